# Optimizing an MI355X kernel written in HIP

```python
import math
import jax, jax.numpy as jnp
from jax import lax
import numpy as np

D_MODEL = 4096
BATCH = 4
SEQ = 2048
DEPTH = 2
DEC_BATCH = 8
DEC_SEQ = 1
PAST_LEN = 16384
PAGE_SIZE = 128

N_A_LAYERS = DEPTH // 2
N_B_LAYERS = DEPTH - N_A_LAYERS

SSM_INNER = 3 * D_MODEL // 4
SSM_HEAD_DIM = 64
SSM_HEADS = SSM_INNER // SSM_HEAD_DIM
SSM_GROUPS = 8
SSM_HPG = SSM_HEADS // SSM_GROUPS
SSM_STATE = 128
SSM_CONV = 4
SSM_CHUNK = 128
SSM_XBC = SSM_INNER + 2 * SSM_GROUPS * SSM_STATE

DIL_PATTERNS = ((128, 1), (512, 4), (2048, 16))
N_DIL = len(DIL_PATTERNS)
DIL_HEADS = 8
HEAD_DIM = 128
ROT_DIM = HEAD_DIM // 4
ROPE_THETA = 500000.0
DIL_Q = N_DIL * DIL_HEADS * HEAD_DIM
DIL_OUT = DIL_HEADS * HEAD_DIM
KV_COLS = N_DIL * 2 * DIL_HEADS * HEAD_DIM
Q_BLOCK = 128

N_MEM = 256
MEM_HEADS = 4
MEM_HEAD_DIM = D_MODEL // 16
MEM_W = MEM_HEADS * MEM_HEAD_DIM

D_FF = 256 * ((8 * D_MODEL // 3 + 255) // 256)
FFN_CONV = 3

EPS = 1e-6
A_IN = SSM_INNER + SSM_XBC + SSM_HEADS + MEM_W
A_SPLITS = [SSM_INNER, SSM_INNER + SSM_XBC, SSM_INNER + SSM_XBC + SSM_HEADS]
B_IN = DIL_Q + MEM_W
A_MIX = SSM_INNER + MEM_W
B_MIX = DIL_OUT + MEM_W

kernel_name = 'yoco_mamba2_dilated_window_hybrid_step'


def rmsnorm(x, g):
    xf = x.astype(jnp.float32)
    y = xf * lax.rsqrt(jnp.mean(xf * xf, axis=-1, keepdims=True) + EPS)
    return (y * g.astype(jnp.float32)).astype(x.dtype)


def rope_partial(x, pos):
    half = ROT_DIM // 2
    inv_freq = jnp.exp(-(2.0 * jnp.arange(half, dtype=jnp.float32) / ROT_DIM) * math.log(ROPE_THETA))
    ang = pos.astype(jnp.float32)[:, None] * inv_freq[None, :]
    shape = (1, pos.shape[0]) + (1,) * (x.ndim - 3) + (half,)
    cos = jnp.cos(ang).reshape(shape)
    sin = jnp.sin(ang).reshape(shape)
    xr = x[..., :ROT_DIM].astype(jnp.float32)
    x1, x2 = xr[..., :half], xr[..., half:]
    rot = jnp.concatenate([x1 * cos - x2 * sin, x2 * cos + x1 * sin], axis=-1).astype(x.dtype)
    return jnp.concatenate([rot, x[..., ROT_DIM:]], axis=-1)


def causal_dwconv(x, prev, w, b):
    width = w.shape[0]
    t_len = x.shape[1]
    xp = jnp.concatenate([prev.astype(x.dtype), x], axis=1)
    y = b + sum(xp[:, k:k + t_len] * w[k] for k in range(width))
    return y, xp[:, xp.shape[1] - (width - 1):]


def ssd_scan(xdt_in, dt, a_neg, bm, cm, h0):
    x = xdt_in
    bsz, t_len = x.shape[:2]
    c = min(SSM_CHUNK, t_len)
    n_c = -(-t_len // c)
    pad = n_c * c - t_len

    def chunks(u):
        u = jnp.pad(u, ((0, 0), (0, pad)) + ((0, 0),) * (u.ndim - 2))
        return jnp.moveaxis(u.reshape((bsz, n_c, c) + u.shape[2:]), 1, 0)

    xdt = x * dt[..., None]
    log_a = dt * a_neg
    tri = jnp.tril(jnp.ones((c, c), dtype=bool))

    def step(h, inp):
        xdt_c, la_c, b_c, c_c = inp
        cum = jnp.cumsum(la_c, axis=1)
        seg = cum[:, :, None] - cum[:, None, :]
        decay = jnp.exp(jnp.where(tri[None, :, :, None, None], seg, -jnp.inf))
        cb = jnp.einsum('btgn,bsgn->btsg', c_c, b_c)
        y = jnp.einsum('btsgh,bsghp->btghp', cb[..., None] * decay, xdt_c)
        y = y + jnp.einsum('btgn,bghpn->btghp', c_c, h) * jnp.exp(cum)[..., None]
        w_end = jnp.exp(cum[:, -1:] - cum)
        h = h * jnp.exp(cum[:, -1])[..., None, None] + jnp.einsum('bsgh,bsghp,bsgn->bghpn', w_end, xdt_c, b_c)
        return h, y

    h_last, ys = lax.scan(step, h0, (chunks(xdt), chunks(log_a), chunks(bm), chunks(cm)))
    y = jnp.moveaxis(ys, 0, 1).reshape((bsz, n_c * c) + x.shape[2:])[:, :t_len]
    return y, h_last


def mamba2_mixer(z, xbc, dt_raw, h_prev, conv_prev, w_conv, b_conv, dt_bias, a_log, d_skip, g_out):
    bsz, t_len, _ = z.shape
    xbc, conv_new = causal_dwconv(xbc, conv_prev, w_conv, b_conv)
    xbc = jax.nn.silu(xbc.astype(jnp.float32))
    xs, bm, cm = jnp.split(xbc, [SSM_INNER, SSM_INNER + SSM_GROUPS * SSM_STATE], axis=-1)
    xs = xs.reshape(bsz, t_len, SSM_GROUPS, SSM_HPG, SSM_HEAD_DIM)
    bm = bm.reshape(bsz, t_len, SSM_GROUPS, SSM_STATE)
    cm = cm.reshape(bsz, t_len, SSM_GROUPS, SSM_STATE)
    dt = jax.nn.softplus(dt_raw.astype(jnp.float32) + dt_bias.astype(jnp.float32))
    dt = dt.reshape(bsz, t_len, SSM_GROUPS, SSM_HPG)
    a_neg = -jnp.exp(a_log.astype(jnp.float32)).reshape(SSM_GROUPS, SSM_HPG)
    h0 = h_prev.astype(jnp.float32).reshape(bsz, SSM_GROUPS, SSM_HPG, SSM_HEAD_DIM, SSM_STATE)
    y, h_last = ssd_scan(xs, dt, a_neg, bm, cm, h0)
    y = y + d_skip.astype(jnp.float32).reshape(SSM_GROUPS, SSM_HPG)[..., None] * xs
    u = (y.reshape(bsz, t_len, SSM_INNER) * jax.nn.silu(z.astype(jnp.float32)))
    u = u.reshape(bsz, t_len, SSM_GROUPS, SSM_INNER // SSM_GROUPS)
    u = u * lax.rsqrt(jnp.mean(u * u, axis=-1, keepdims=True) + EPS)
    u = u.reshape(bsz, t_len, SSM_INNER) * g_out.astype(jnp.float32)
    h_out = h_last.reshape(bsz, SSM_HEADS, SSM_HEAD_DIM, SSM_STATE).astype(h_prev.dtype)
    return u.astype(z.dtype), h_out, conv_new


def memory_kv(mem, g_norm, w_kv, g_k):
    bsz, n, _ = mem.shape
    kv = (rmsnorm(mem, g_norm) @ w_kv).reshape(bsz, n, 2, MEM_HEADS, MEM_HEAD_DIM)
    k = rmsnorm(kv[:, :, 0], g_k)
    return jnp.stack([k, kv[:, :, 1]], axis=2)


def memory_attention(q, mem_kv):
    s = jnp.einsum('bthd,bmhd->bhtm', q.astype(jnp.float32), mem_kv[:, :, 0].astype(jnp.float32)) * (MEM_HEAD_DIM ** -0.5)
    p = jax.nn.softmax(s, axis=-1)
    o = jnp.einsum('bhtm,bmhd->bthd', p, mem_kv[:, :, 1].astype(jnp.float32))
    return o.astype(q.dtype)


def shared_window_kv(x, pos, g_norm, w_kv, g_k):
    bsz, t_len, _ = x.shape
    kv = (rmsnorm(x, g_norm) @ w_kv).reshape(bsz, t_len, N_DIL, 2, DIL_HEADS, HEAD_DIM)
    k = rope_partial(rmsnorm(kv[:, :, :, 0], g_k[:, None, :]), pos)
    return jnp.stack([k, kv[:, :, :, 1]], axis=3)


def dilated_attention(q, kv_full, past_lens):
    bsz, t_len = q.shape[:2]
    bq = min(Q_BLOCK, t_len)
    n_blk = -(-t_len // bq)
    pad = n_blk * bq - t_len
    qp = jnp.pad(q, ((0, 0), (0, pad), (0, 0), (0, 0), (0, 0)))
    kvp = [jnp.pad(kv, ((0, 0), (w, pad), (0, 0), (0, 0), (0, 0))) for kv, (w, _) in zip(kv_full, DIL_PATTERNS)]
    scale = HEAD_DIM ** -0.5
    i_idx = np.arange(bq)[:, None]

    def block(q0):
        qb = lax.dynamic_slice_in_dim(qp, q0, bq, axis=1).astype(jnp.float32)
        outs, lses = [], []
        for g, (w, r) in enumerate(DIL_PATTERNS):
            n_k = w // r + 1
            k_idx = np.arange(n_k)[None, :]
            sl = lax.dynamic_slice_in_dim(kvp[g], q0 + past_lens[g], bq + w, axis=1)
            kvg = sl[:, i_idx + w - k_idx * r].astype(jnp.float32)
            valid = (q0 + past_lens[g] + i_idx - k_idx * r) >= 0
            s = jnp.einsum('bqhd,bqkhd->bhqk', qb[:, :, g], kvg[:, :, :, 0]) * scale
            s = jnp.where(valid[None, None], s, -jnp.inf)
            m = jnp.max(s, axis=-1, keepdims=True)
            p = jnp.exp(s - m)
            den = jnp.sum(p, axis=-1, keepdims=True)
            o = jnp.einsum('bhqk,bqkhd->bqhd', p / den, kvg[:, :, :, 1])
            outs.append(o)
            lses.append((m + jnp.log(den))[..., 0])
        wts = jax.nn.softmax(jnp.stack(lses, axis=0), axis=0)
        wts = jnp.swapaxes(wts, 2, 3)[..., None]
        return jnp.sum(wts * jnp.stack(outs, axis=0), axis=0).astype(q.dtype)

    ob = lax.map(block, jnp.arange(n_blk, dtype=jnp.int32) * bq)
    o = jnp.moveaxis(ob, 0, 1).reshape(bsz, n_blk * bq, DIL_HEADS, HEAD_DIM)
    return o[:, :t_len]


def conv_ffn(x, prev, g, w_up, w_conv, b_conv, w_down):
    gate, up = jnp.split(rmsnorm(x, g) @ w_up, [D_FF], axis=-1)
    gate, new_prev = causal_dwconv(gate, prev, w_conv, b_conv)
    return (jax.nn.silu(gate) * up) @ w_down, new_prev


def trunk(x, pos, mem_kv, ssm_prev, ssm_conv_prev, ffn_prev, win_past, p):
    bsz, t_len, _ = x.shape
    ssm_out, ssm_conv_out, ffn_out = [], [], []
    kv_new, kv_full = None, None
    past_lens = [wp.shape[1] for wp in win_past]
    for i in range(DEPTH):
        h = rmsnorm(x, p['g_mix'][i])
        if i < N_A_LAYERS:
            a = i
            z, xbc, dt_raw, q_mem = jnp.split(h @ p['w_in_a'][a], A_SPLITS, axis=-1)
            y_mix, s_new, c_new = mamba2_mixer(z, xbc, dt_raw, ssm_prev[a], ssm_conv_prev[a], p['w_conv_a'][a], p['b_conv_a'][a], p['dt_bias_a'][a], p['a_log_a'][a], p['d_skip_a'][a], p['g_ssm_out_a'][a])
            ssm_out.append(s_new)
            ssm_conv_out.append(c_new)
            w_out = p['w_out_a'][a]
        else:
            b = i - N_A_LAYERS
            if i == N_A_LAYERS:
                kv_new = shared_window_kv(x, pos, p['g_kv'], p['w_kv'], p['g_k_dil'])
                kv_full = [jnp.concatenate([win_past[g].astype(x.dtype), kv_new[:, :, g]], axis=1) for g in range(N_DIL)]
            q_dil, q_mem = jnp.split(h @ p['w_in_b'][b], [DIL_Q], axis=-1)
            q = rmsnorm(q_dil.reshape(bsz, t_len, N_DIL, DIL_HEADS, HEAD_DIM), p['g_q_dil'][b][:, None, :])
            q = rope_partial(q, pos)
            y_mix = dilated_attention(q, kv_full, past_lens).reshape(bsz, t_len, DIL_OUT)
            w_out = p['w_out_b'][b]
        qm = rmsnorm(q_mem.reshape(bsz, t_len, MEM_HEADS, MEM_HEAD_DIM), p['g_mem_q'][i])
        y_mem = memory_attention(qm, mem_kv[i]).reshape(bsz, t_len, MEM_W)
        x = x + jnp.concatenate([y_mix.astype(x.dtype), y_mem.astype(x.dtype)], axis=-1) @ w_out
        f, f_new = conv_ffn(x, ffn_prev[i], p['g_ffn'][i], p['w_ffn_up'][i], p['w_ffn_conv'][i], p['b_ffn_conv'][i], p['w_ffn_down'][i])
        ffn_out.append(f_new)
        x = x + f
    return x, jnp.stack(ssm_out, axis=0), jnp.stack(ssm_conv_out, axis=0), jnp.stack(ffn_out, axis=0), kv_new


def setup_inputs(seed: int = 0) -> dict:
    key = jax.random.key(seed)
    ks = iter(jax.random.split(key, 48))
    f32 = jnp.float32

    def nrm(shape, scale=1.0):
        return jax.random.normal(next(ks), shape, f32) * scale

    def gain(shape):
        return 1.0 + nrm(shape, 0.02)

    n_a, n_b = N_A_LAYERS, N_B_LAYERS
    l_win = [min(w, PAST_LEN) for w, _ in DIL_PATTERNS]
    inp = {}
    inp['x_prompt'] = nrm((BATCH, SEQ, D_MODEL))
    inp['x_sample'] = nrm((DEC_BATCH, DEC_SEQ, D_MODEL))
    inp['state_ssm'] = nrm((n_a, DEC_BATCH, SSM_HEADS, SSM_HEAD_DIM, SSM_STATE), 0.5)
    inp['state_ssm_conv'] = nrm((n_a, DEC_BATCH, SSM_CONV - 1, SSM_XBC))
    inp['state_ffn_conv'] = nrm((DEPTH, DEC_BATCH, FFN_CONV - 1, D_FF))
    inp['cache_mem_kv'] = nrm((DEPTH, DEC_BATCH, N_MEM, 2, MEM_HEADS, MEM_HEAD_DIM))
    inp['cache_win_kv0'] = nrm((DEC_BATCH, l_win[0], 2, DIL_HEADS, HEAD_DIM))
    inp['cache_win_kv1'] = nrm((DEC_BATCH, l_win[1], 2, DIL_HEADS, HEAD_DIM))
    inp['cache_win_kv2'] = nrm((DEC_BATCH, l_win[2], 2, DIL_HEADS, HEAD_DIM))
    inp['mem_prompt'] = nrm((BATCH, N_MEM, D_MODEL))
    inp['g_mix'] = gain((DEPTH, D_MODEL))
    inp['w_in_a'] = nrm((n_a, D_MODEL, A_IN), D_MODEL ** -0.5)
    inp['w_conv_a'] = nrm((n_a, SSM_CONV, SSM_XBC), SSM_CONV ** -0.5)
    inp['b_conv_a'] = nrm((n_a, SSM_XBC), 0.02)
    dt0 = jnp.exp(jax.random.uniform(next(ks), (n_a, SSM_HEADS), f32, math.log(1e-3), math.log(1e-1)))
    inp['dt_bias_a'] = dt0 + jnp.log(-jnp.expm1(-dt0))
    inp['a_log_a'] = jnp.log(jax.random.uniform(next(ks), (n_a, SSM_HEADS), f32, 1.0, 16.0))
    inp['d_skip_a'] = 1.0 + nrm((n_a, SSM_HEADS), 0.1)
    inp['g_ssm_out_a'] = gain((n_a, SSM_INNER))
    inp['w_out_a'] = nrm((n_a, A_MIX, D_MODEL), A_MIX ** -0.5)
    inp['g_kv'] = gain((D_MODEL,))
    inp['w_kv'] = nrm((D_MODEL, KV_COLS), D_MODEL ** -0.5)
    inp['g_k_dil'] = gain((N_DIL, HEAD_DIM))
    inp['w_in_b'] = nrm((n_b, D_MODEL, B_IN), D_MODEL ** -0.5)
    inp['g_q_dil'] = gain((n_b, N_DIL, HEAD_DIM))
    inp['w_out_b'] = nrm((n_b, B_MIX, D_MODEL), B_MIX ** -0.5)
    inp['g_mem'] = gain((DEPTH, D_MODEL))
    inp['w_mem_kv'] = nrm((DEPTH, D_MODEL, 2 * MEM_W), D_MODEL ** -0.5)
    inp['g_mem_q'] = gain((DEPTH, MEM_HEAD_DIM))
    inp['g_mem_k'] = gain((DEPTH, MEM_HEAD_DIM))
    inp['g_ffn'] = gain((DEPTH, D_MODEL))
    inp['w_ffn_up'] = nrm((DEPTH, D_MODEL, 2 * D_FF), D_MODEL ** -0.5)
    inp['w_ffn_conv'] = nrm((DEPTH, FFN_CONV, D_FF), FFN_CONV ** -0.5)
    inp['b_ffn_conv'] = nrm((DEPTH, D_FF), 0.02)
    inp['w_ffn_down'] = nrm((DEPTH, D_FF, D_MODEL), D_FF ** -0.5)
    return inp


def reference(x_prompt, x_sample, state_ssm, state_ssm_conv, state_ffn_conv, cache_mem_kv, cache_win_kv0, cache_win_kv1, cache_win_kv2, mem_prompt, g_mix, w_in_a, w_conv_a, b_conv_a, dt_bias_a, a_log_a, d_skip_a, g_ssm_out_a, w_out_a, g_kv, w_kv, g_k_dil, w_in_b, g_q_dil, w_out_b, g_mem, w_mem_kv, g_mem_q, g_mem_k, g_ffn, w_ffn_up, w_ffn_conv, b_ffn_conv, w_ffn_down):
    p = dict(g_mix=g_mix, w_in_a=w_in_a, w_conv_a=w_conv_a, b_conv_a=b_conv_a, dt_bias_a=dt_bias_a, a_log_a=a_log_a, d_skip_a=d_skip_a, g_ssm_out_a=g_ssm_out_a, w_out_a=w_out_a, g_kv=g_kv, w_kv=w_kv, g_k_dil=g_k_dil, w_in_b=w_in_b, g_q_dil=g_q_dil, w_out_b=w_out_b, g_mem_q=g_mem_q, g_ffn=g_ffn, w_ffn_up=w_ffn_up, w_ffn_conv=w_ffn_conv, b_ffn_conv=b_ffn_conv, w_ffn_down=w_ffn_down)
    bp, sp = x_prompt.shape[0], x_prompt.shape[1]
    ds = x_sample.shape[1]
    dt_p = x_prompt.dtype
    mem_kv_p = jnp.stack([memory_kv(mem_prompt, g_mem[i], w_mem_kv[i], g_mem_k[i]) for i in range(DEPTH)], axis=0)
    ssm0 = jnp.zeros((N_A_LAYERS, bp, SSM_HEADS, SSM_HEAD_DIM, SSM_STATE), dt_p)
    conv0 = jnp.zeros((N_A_LAYERS, bp, SSM_CONV - 1, SSM_XBC), dt_p)
    ffn0 = jnp.zeros((DEPTH, bp, FFN_CONV - 1, D_FF), dt_p)
    win0 = [jnp.zeros((bp, 0, 2, DIL_HEADS, HEAD_DIM), dt_p) for _ in range(N_DIL)]
    y_p, ssm_p, conv_p, ffn_p, kv_p = trunk(x_prompt, jnp.arange(sp, dtype=jnp.int32), mem_kv_p, ssm0, conv0, ffn0, win0, p)
    pos_s = PAST_LEN + jnp.arange(ds, dtype=jnp.int32)
    y_s, ssm_s, conv_s, ffn_s, kv_s = trunk(x_sample, pos_s, cache_mem_kv, state_ssm, state_ssm_conv, state_ffn_conv, [cache_win_kv0, cache_win_kv1, cache_win_kv2], p)
    l0 = min(DIL_PATTERNS[0][0], sp)
    l1 = min(DIL_PATTERNS[1][0], sp)
    l2 = min(DIL_PATTERNS[2][0], sp)
    return (y_p, y_s, ssm_p, ssm_s, conv_p, conv_s, ffn_p, ffn_s, mem_kv_p, kv_p[:, sp - l0:, 0], kv_p[:, sp - l1:, 1], kv_p[:, sp - l2:, 2], kv_s[:, :, 0], kv_s[:, :, 1], kv_s[:, :, 2])
```

```cpp
#include <hip/hip_runtime.h>
#include <cstdio>
#include <cstdint>


#ifndef MK_SPLIT
#define MK_SPLIT 0
#endif

__device__ __forceinline__ int lane_id() { int l; asm volatile("v_mbcnt_lo_u32_b32 %0, -1, 0\n\tv_mbcnt_hi_u32_b32 %0, -1, %0" : "=v"(l)); return l; }
namespace pg8 {
#define PG8_LAS __attribute__((address_space(3)))
typedef unsigned short bf16_t;
typedef short bf16x8 __attribute__((ext_vector_type(8)));
typedef float f32x4 __attribute__((ext_vector_type(4)));
typedef unsigned u32x4 __attribute__((ext_vector_type(4)));
typedef unsigned u32x2 __attribute__((ext_vector_type(2)));
constexpr int BM = 256, BK = 64, HALF = 128, HTB = HALF * BK * 2, STAGE_BYTES = 8 * HTB, NXCD = 8, WGM = 8;

__host__ __device__ __forceinline__ int lds_byte(int r, int c) { const int st = (r >> 4) * 2 + (c >> 5), rr = r & 15, cc = c & 31, ob = rr * 64 + cc * 2; return st * 1024 + (ob ^ (((ob >> 9) & 1) << 5)); }
__host__ __device__ __forceinline__ void stage_rc(int b, int& R, int& C) { const int st = b / 1024, sb = b % 1024, swz = sb ^ (((sb >> 9) & 1) << 5); R = (st >> 1) * 16 + swz / 64; C = (st & 1) * 32 + (swz % 64) / 2; }
__host__ __device__ __forceinline__ int perm32(int rho) { const int n = rho >> 4, i = rho & 15; return 8 * (i >> 2) + 4 * n + (i & 3); }

struct Unit { int pm, pn; };
struct Gemm { const bf16_t* A; const bf16_t* Bt; int M, N, K, lda, ldb; };

struct StaticOrder {
    int nM, nN, nwg, G, c;
    __host__ __device__ void init(int M, int N, int G_, int c_) { nM = M / BM; nN = N / BM; nwg = nM * nN; G = G_; c = c_; }
    __host__ __device__ bool next(int i, Unit& u) const {
        const long L = (long)i * G + c; if (L >= nwg) return false;
        int wgid = (int)L; { const int q = nwg / NXCD, r = nwg % NXCD, xcd = wgid % NXCD, off = wgid / NXCD; wgid = (xcd < r ? xcd * (q + 1) : r * (q + 1) + (xcd - r) * q) + off; }
        const int nig = WGM * nN, gid = wgid / nig, fm = gid * WGM, gsz = (nM - fm) < WGM ? (nM - fm) : WGM;
        u.pm = fm + ((wgid % nig) % gsz); u.pn = (wgid % nig) / gsz; return true;
    }
    __device__ __forceinline__ void a_ready(const Unit&) const {}
    __device__ __forceinline__ void done(const Unit&) const {}
};

__device__ __forceinline__ unsigned cvt_pk_bf16(float lo, float hi) { unsigned r; asm volatile("v_cvt_pk_bf16_f32 %0, %1, %2" : "=v"(r) : "v"(lo), "v"(hi)); return r; }

constexpr int SSQ_SLOTS = 64;
constexpr float NORM_EPS = 1e-6f;

__device__ __forceinline__ void row_scales_lds(const float* ssq, int pm, int wid, int lane, PG8_LAS float* tab) {
    const int t = wid * 64 + lane, row = t >> 1;
    const f32x4* sp = (const f32x4*)(ssq + (size_t)(pm * BM + row) * SSQ_SLOTS + 32 * (t & 1));
    f32x4 v[8];
#pragma unroll
    for (int j = 0; j < 8; ++j) v[j] = sp[j];
    const f32x4 s4 = ((v[0] + v[1]) + (v[2] + v[3])) + ((v[4] + v[5]) + (v[6] + v[7]));
    float sm = (s4[0] + s4[1]) + (s4[2] + s4[3]); sm += __shfl_xor(sm, 1);
    if ((t & 1) == 0) tab[row] = 1.0f / sqrtf(sm * (1.0f / 4096.0f) + NORM_EPS);
}
#define PG8_LDS_BARRIER() do { asm volatile("s_waitcnt lgkmcnt(0)" ::: "memory"); __builtin_amdgcn_s_barrier(); asm volatile("" ::: "memory"); } while (0)
struct EpiScale {
    static constexpr bool PERM = true, AFTER_DRAIN = false;
    bf16_t* O; int ldc; const float* ssq; PG8_LAS float* tab;
    __device__ __forceinline__ void operator()(const f32x4 (&acc)[2][2][4][2], const Unit& u, int wr, int wc, int fr, int fq) const {
        const int row0 = u.pm * BM + wr * 64 + fr, col0 = u.pn * BM + wc * 32 + 8 * fq;
        if (ssq) { row_scales_lds(ssq, u.pm, wr * 4 + wc, fq * 16 + fr, tab); PG8_LDS_BARRIER(); }
#pragma unroll
        for (int ai = 0; ai < 2; ++ai)
#pragma unroll
            for (int m = 0; m < 4; ++m) {
                const int row = row0 + ai * HALF + m * 16;
                const float rs = ssq ? tab[ai * HALF + wr * 64 + m * 16 + fr] : 1.f;
                bf16_t* rowp = O + (size_t)row * ldc + col0;
#pragma unroll
                for (int bj = 0; bj < 2; ++bj) { const f32x4 v0 = acc[ai][bj][m][0] * rs, v1 = acc[ai][bj][m][1] * rs; u32x4 w; w.x = cvt_pk_bf16(v0[0], v0[1]); w.y = cvt_pk_bf16(v0[2], v0[3]); w.z = cvt_pk_bf16(v1[0], v1[1]); w.w = cvt_pk_bf16(v1[2], v1[3]);
                    *(u32x4*)(rowp + bj * HALF) = w; }
            }
    }
};
template <bool FINAL> struct EpiResid {
    static constexpr bool PERM = true, AFTER_DRAIN = false;
    float* out; bf16_t* xb; float* ssq; int ldxb;
    __device__ __forceinline__ void operator()(const f32x4 (&acc)[2][2][4][2], const Unit& u, int wr, int wc, int fr, int fq) const {
        const int row0 = u.pm * BM + wr * 64 + fr, col0 = u.pn * BM + wc * 32 + 8 * fq;
        u32x4 r[2][4][2];
#pragma unroll
        for (int ai = 0; ai < 2; ++ai)
#pragma unroll
            for (int m = 0; m < 4; ++m)
#pragma unroll
                for (int bj = 0; bj < 2; ++bj) r[ai][m][bj] = *(const u32x4*)(xb + (size_t)(row0 + ai * HALF + m * 16) * ldxb + col0 + bj * HALF);
#pragma unroll
        for (int ai = 0; ai < 2; ++ai)
#pragma unroll
            for (int m = 0; m < 4; ++m) {
                const int row = row0 + ai * HALF + m * 16;
                bf16_t* xp = xb + (size_t)row * ldxb + col0; float ss = 0.f;
#pragma unroll
                for (int bj = 0; bj < 2; ++bj) { const u32x4 rr = r[ai][m][bj];
                    const f32x4 v0 = acc[ai][bj][m][0] + (f32x4){__builtin_bit_cast(float, rr.x << 16), __builtin_bit_cast(float, rr.x & 0xffff0000u), __builtin_bit_cast(float, rr.y << 16), __builtin_bit_cast(float, rr.y & 0xffff0000u)};
                    const f32x4 v1 = acc[ai][bj][m][1] + (f32x4){__builtin_bit_cast(float, rr.z << 16), __builtin_bit_cast(float, rr.z & 0xffff0000u), __builtin_bit_cast(float, rr.w << 16), __builtin_bit_cast(float, rr.w & 0xffff0000u)};
                    if constexpr (FINAL) { float* op = out + (size_t)row * 4096 + col0 + bj * HALF; *(f32x4*)op = v0; *(f32x4*)(op + 4) = v1; }
                    else { u32x4 w; w.x = cvt_pk_bf16(v0[0], v0[1]); w.y = cvt_pk_bf16(v0[2], v0[3]); w.z = cvt_pk_bf16(v1[0], v1[1]); w.w = cvt_pk_bf16(v1[2], v1[3]); *(u32x4*)(xp + bj * HALF) = w;
                        ss += ((v0[0] * v0[0] + v0[1] * v0[1]) + (v0[2] * v0[2] + v0[3] * v0[3])) + ((v1[0] * v1[0] + v1[1] * v1[1]) + (v1[2] * v1[2] + v1[3] * v1[3])); } }
                if constexpr (!FINAL) { ss += __shfl_xor(ss, 16); ss += __shfl_xor(ss, 32); if (fq == 0) ssq[(size_t)row * SSQ_SLOTS + u.pn * 4 + wc] = ss; }
            }
    }
};

__device__ __forceinline__ float dpp_ror1(float x) { return __builtin_bit_cast(float, __builtin_amdgcn_update_dpp(0, __builtin_bit_cast(int, x), 0x121, 0xf, 0xf, true)); }
__device__ __forceinline__ float dpp_ror2(float x) { return __builtin_bit_cast(float, __builtin_amdgcn_update_dpp(0, __builtin_bit_cast(int, x), 0x122, 0xf, 0xf, true)); }
struct EpiFFN {
    static constexpr bool PERM = true, AFTER_DRAIN = false;
    bf16_t* H; int ldh; const float* ssq; const float* wcv; const float* bcv; float* tail; float* headg; float* headu; float* ffnp; PG8_LAS float* halo; int dff;
    __device__ __forceinline__ void operator()(const f32x4 (&acc)[2][2][4][2], const Unit& u, int wr, int wc, int fr, int fq) const {
        const int ch0 = u.pn * 128 + wc * 32 + 8 * fq;
        f32x4 w0[2], w1[2], w2[2], bb[2];
#pragma unroll
        for (int n = 0; n < 2; ++n) { w0[n] = *(const f32x4*)(wcv + ch0 + 4 * n); w1[n] = *(const f32x4*)(wcv + dff + ch0 + 4 * n); w2[n] = *(const f32x4*)(wcv + 2 * dff + ch0 + 4 * n); bb[n] = *(const f32x4*)(bcv + ch0 + 4 * n); }
        row_scales_lds(ssq, u.pm, wr * 4 + wc, fq * 16 + fr, halo + 2048); PG8_LDS_BARRIER();
        float rsv[2][4];
#pragma unroll
        for (int ai = 0; ai < 2; ++ai)
#pragma unroll
            for (int m = 0; m < 4; ++m) rsv[ai][m] = halo[2048 + ai * HALF + wr * 64 + m * 16 + fr];
#pragma unroll
        for (int ai = 0; ai < 2; ++ai) { const float r3 = rsv[ai][3];
            if (fr >= 14) {
#pragma unroll
                for (int n = 0; n < 2; ++n) *(PG8_LAS f32x4*)(halo + ((((ai * 2 + wr) * 4 + wc) * 2 + (fr - 14)) * 4 + fq) * 8 + 4 * n) = acc[ai][0][3][n] * r3; } }
        asm volatile("s_waitcnt lgkmcnt(0)" ::: "memory"); __builtin_amdgcn_s_barrier(); asm volatile("" ::: "memory");
#pragma unroll
        for (int ai = 0; ai < 2; ++ai) {
            const bool top = (ai == 0 && wr == 0);
            f32x4 pg[2];
            if (!top) { const int pai = (wr == 1) ? ai : ai - 1, pwr = (wr == 1) ? 0 : 1;
#pragma unroll
                for (int n = 0; n < 2; ++n) { const f32x4 h14 = *(const PG8_LAS f32x4*)(halo + ((((pai * 2 + pwr) * 4 + wc) * 2 + 0) * 4 + fq) * 8 + 4 * n), h15 = *(const PG8_LAS f32x4*)(halo + ((((pai * 2 + pwr) * 4 + wc) * 2 + 1) * 4 + fq) * 8 + 4 * n);
                    pg[n] = (fr == 14) ? h14 : h15; } }
            else { pg[0] = (f32x4){0.f, 0.f, 0.f, 0.f}; pg[1] = pg[0]; }
#pragma unroll
            for (int m = 0; m < 4; ++m) {
                const int row = u.pm * BM + ai * HALF + wr * 64 + m * 16 + fr; const float rsm = rsv[ai][m];
                f32x4 hq[2];
#pragma unroll
                for (int n = 0; n < 2; ++n) {
                    const f32x4 gq = acc[ai][0][m][n] * rsm, uq = acc[ai][1][m][n] * rsm;
#pragma unroll
                    for (int i = 0; i < 4; ++i) {
                        const float x1 = (fr == 15) ? pg[n][i] : gq[i], x2 = (fr >= 14) ? pg[n][i] : gq[i];
                        const float p1 = dpp_ror1(x1), p2 = dpp_ror2(x2);
                        const float y = __builtin_fmaf(w2[n][i], gq[i], __builtin_fmaf(w1[n][i], p1, __builtin_fmaf(w0[n][i], p2, bb[n][i])));
                        hq[n][i] = y * __builtin_amdgcn_rcpf(1.0f + __expf(-y)) * uq[i]; }
                    const int ch = ch0 + 4 * n;
                    if (top && m == 0 && fr < 2) { *(f32x4*)(headg + ((size_t)u.pm * 2 + fr) * dff + ch) = gq; *(f32x4*)(headu + ((size_t)u.pm * 2 + fr) * dff + ch) = uq; }
                    if (ai == 1 && wr == 1 && m == 3 && fr >= 14) { *(f32x4*)(tail + ((size_t)u.pm * 2 + (fr - 14)) * dff + ch) = gq;
                        if ((u.pm & 7) == 7) *(f32x4*)(ffnp + ((size_t)(u.pm >> 3) * 2 + (fr - 14)) * dff + ch) = gq; }
                    pg[n] = gq;
                }
                if (!(top && m == 0 && fr < 2)) { u32x4 wv; wv.x = cvt_pk_bf16(hq[0][0], hq[0][1]); wv.y = cvt_pk_bf16(hq[0][2], hq[0][3]); wv.z = cvt_pk_bf16(hq[1][0], hq[1][1]); wv.w = cvt_pk_bf16(hq[1][2], hq[1][3]); *(u32x4*)(H + (size_t)row * ldh + ch0) = wv; }
            }
        }
    }
};

template <class Epi, class Sched, bool ALIGN_EPI = false, bool SP2 = false>
__device__ __forceinline__ void gemm_phase(PG8_LAS unsigned char* lds, const Gemm g, const Sched& S, const Epi& E, int wave_id) {
    const int wid = wave_id, lane = lane_id(), tid = wid * 64 + lane, wr = wid >> 2, wc = wid & 3, fr = lane & 15, fq = lane >> 4;
    const int K = g.K, nt = K / BK;
    unsigned voffA[2], voffB[2];
#pragma unroll
    for (int i = 0; i < 2; ++i) { int R, C; stage_rc(tid * 16 + i * 8192, R, C); const int Rb = Epi::PERM ? ((R & ~31) + perm32(R & 31)) : R;
        voffA[i] = (unsigned)(R * g.lda + C) * 2u; voffB[i] = (unsigned)(Rb * g.ldb + C) * 2u; }
    const size_t kstep = (size_t)(BK * 2);
    const size_t hstepA = (size_t)HALF * g.lda * 2, hstepB = (size_t)HALF * g.ldb * 2;
    const size_t tstepA = 2 * hstepA, tstepB = 2 * hstepB;
    const unsigned ldsw = (unsigned)wid * 1024u;
    const int aoff = lds_byte(wr * 64 + fr, fq * 8), boff = lds_byte(wc * 32 + fr, fq * 8);
#define PG8_SA(b, h) (((b) * 2 + (h)) * HTB)
#define PG8_SB(b, h) ((4 + (b) * 2 + (h)) * HTB)
#define PG8_STAGE(bufoff, gbase, voff) do { _Pragma("unroll") for (int _i = 0; _i < 2; ++_i) \
        __builtin_amdgcn_global_load_lds((const unsigned*)((const char*)(gbase) + (voff)[_i]), (PG8_LAS unsigned*)(lds + (bufoff) + ldsw + _i * 8192), 16, 0, 0); } while (0)
#define PG8_LDA(dst, b, h) do { _Pragma("unroll") for (int m = 0; m < 4; ++m) _Pragma("unroll") for (int k = 0; k < 2; ++k) dst[m][k] = *(const PG8_LAS bf16x8*)(lds + PG8_SA(b, h) + aoff + m * 2048 + k * 1024); } while (0)
#define PG8_LDB(dst, b, h) do { _Pragma("unroll") for (int n = 0; n < 2; ++n) _Pragma("unroll") for (int k = 0; k < 2; ++k) dst[n][k] = *(const PG8_LAS bf16x8*)(lds + PG8_SB(b, h) + boff + n * 2048 + k * 1024); } while (0)
#define PG8_MMA(ai, bj, At, Bt) do { __builtin_amdgcn_s_setprio(1); _Pragma("unroll") for (int m = 0; m < 4; ++m) _Pragma("unroll") for (int n = 0; n < 2; ++n) _Pragma("unroll") for (int k = 0; k < 2; ++k) \
        acc[ai][bj][m][n] = __builtin_amdgcn_mfma_f32_16x16x32_bf16(Bt[n][k], At[m][k], acc[ai][bj][m][n], 0, 0, 0); __builtin_amdgcn_s_setprio(0); } while (0)
#define PG8_WAIT_V(n) asm volatile("s_waitcnt vmcnt(" #n ")" ::: "memory")
#define PG8_WAIT_L(n) asm volatile("s_waitcnt lgkmcnt(" #n ")" ::: "memory")
#define PG8_BAR __builtin_amdgcn_s_barrier()
#define PG8_SCHED __builtin_amdgcn_sched_barrier(0)
    Unit cur, nxt; int ui = 0;
    if (!S.next(0, cur)) return;
    f32x4 acc[2][2][4][2];
#pragma unroll
    for (int a = 0; a < 2; ++a)
#pragma unroll
        for (int b = 0; b < 2; ++b)
#pragma unroll
            for (int m = 0; m < 4; ++m)
#pragma unroll
                for (int n = 0; n < 2; ++n) acc[a][b][m][n] = (f32x4){0.f, 0.f, 0.f, 0.f};
    bf16x8 At[4][2], B0[2][2], B1[2][2];
    const char* cA = (const char*)g.A + (size_t)cur.pm * tstepA; const char* cB = (const char*)g.Bt + (size_t)cur.pn * tstepB;
    S.a_ready(cur);
    if constexpr (SP2) {
        PG8_STAGE(PG8_SB(0, 0), cB, voffB); PG8_STAGE(PG8_SB(0, 1), cB + hstepB, voffB); PG8_STAGE(PG8_SA(0, 0), cA, voffA); PG8_STAGE(PG8_SA(0, 1), cA + hstepA, voffA);
        if (wr == 1) PG8_BAR;
        PG8_WAIT_V(2); PG8_BAR;
        PG8_STAGE(PG8_SB(1, 0), cB + kstep, voffB); PG8_STAGE(PG8_SA(1, 0), cA + kstep, voffA); PG8_STAGE(PG8_SB(1, 1), cB + hstepB + kstep, voffB);
        PG8_WAIT_V(6); PG8_BAR;
    } else {
        PG8_STAGE(PG8_SB(0, 0), cB, voffB); PG8_STAGE(PG8_SA(0, 0), cA, voffA); PG8_STAGE(PG8_SB(0, 1), cB + hstepB, voffB); PG8_STAGE(PG8_SA(0, 1), cA + hstepA, voffA);
        if (wr == 1) PG8_BAR;
        PG8_WAIT_V(4); PG8_BAR;
        PG8_STAGE(PG8_SB(1, 0), cB + kstep, voffB); PG8_STAGE(PG8_SA(1, 0), cA + kstep, voffA); PG8_STAGE(PG8_SB(1, 1), cB + hstepB + kstep, voffB);
        PG8_WAIT_V(6); PG8_BAR;
    }
    for (;;) {
        const bool has_next = S.next(ui + 1, nxt);
        const char* nA = has_next ? (const char*)g.A + (size_t)nxt.pm * tstepA : cA; const char* nB = has_next ? (const char*)g.Bt + (size_t)nxt.pn * tstepB : cB;
        for (int t = 0; t < nt; t += 2) {
            const bool last = (t == nt - 2);
            const char* a1 = cA + (size_t)(t + 1) * kstep;
            const char* a2 = last ? nA : cA + (size_t)(t + 2) * kstep; const char* b2 = last ? nB : cB + (size_t)(t + 2) * kstep;
            const char* a3 = a2 + kstep; const char* b3 = b2 + kstep;
            if (last && has_next) S.a_ready(nxt);
            if constexpr (SP2) {
            PG8_LDB(B0, 0, 0); PG8_LDB(B1, 0, 1); PG8_SCHED; PG8_LDA(At, 0, 0); PG8_STAGE(PG8_SA(1, 1), a1 + hstepA, voffA);
            PG8_WAIT_V(8); PG8_WAIT_L(0); PG8_BAR; PG8_MMA(0, 0, At, B0); PG8_MMA(0, 1, At, B1); PG8_BAR; PG8_SCHED;
            PG8_LDA(At, 0, 1); PG8_STAGE(PG8_SB(0, 0), b2, voffB); PG8_STAGE(PG8_SB(0, 1), b2 + hstepB, voffB); PG8_STAGE(PG8_SA(0, 0), a2, voffA);
            PG8_WAIT_V(8); PG8_WAIT_L(0); PG8_BAR; PG8_MMA(1, 0, At, B0); PG8_MMA(1, 1, At, B1); PG8_BAR; PG8_SCHED;
            PG8_LDB(B0, 1, 0); PG8_LDB(B1, 1, 1); PG8_SCHED; PG8_LDA(At, 1, 0); PG8_STAGE(PG8_SA(0, 1), a2 + hstepA, voffA);
            PG8_WAIT_V(8); PG8_WAIT_L(0); PG8_BAR; PG8_MMA(0, 0, At, B0); PG8_MMA(0, 1, At, B1); PG8_BAR; PG8_SCHED;
            PG8_LDA(At, 1, 1); PG8_STAGE(PG8_SB(1, 0), b3, voffB); PG8_STAGE(PG8_SB(1, 1), b3 + hstepB, voffB); PG8_STAGE(PG8_SA(1, 0), a3, voffA);
            PG8_WAIT_V(8); PG8_WAIT_L(0); PG8_BAR; PG8_MMA(1, 0, At, B0); PG8_MMA(1, 1, At, B1); PG8_BAR; PG8_SCHED;
            } else {
            PG8_LDB(B0, 0, 0); PG8_SCHED; PG8_LDA(At, 0, 0); PG8_STAGE(PG8_SA(1, 1), a1 + hstepA, voffA);
            PG8_WAIT_L(8); PG8_BAR; PG8_WAIT_L(0); PG8_MMA(0, 0, At, B0); PG8_BAR; PG8_SCHED;
            PG8_LDB(B1, 0, 1); PG8_STAGE(PG8_SB(0, 0), b2, voffB);
            PG8_BAR; PG8_WAIT_L(0); PG8_MMA(0, 1, At, B1); PG8_BAR;
            PG8_LDA(At, 0, 1); PG8_STAGE(PG8_SA(0, 0), a2, voffA);
            PG8_BAR; PG8_WAIT_L(0); PG8_MMA(1, 0, At, B0); PG8_BAR; PG8_SCHED;
            PG8_STAGE(PG8_SB(0, 1), b2 + hstepB, voffB);
            PG8_WAIT_V(6); PG8_BAR; PG8_MMA(1, 1, At, B1); PG8_BAR;
            PG8_LDB(B0, 1, 0); PG8_SCHED; PG8_LDA(At, 1, 0); PG8_STAGE(PG8_SA(0, 1), a2 + hstepA, voffA);
            PG8_WAIT_L(8); PG8_BAR; PG8_WAIT_L(0); PG8_MMA(0, 0, At, B0); PG8_BAR; PG8_SCHED;
            PG8_LDB(B1, 1, 1); PG8_STAGE(PG8_SB(1, 0), b3, voffB);
            PG8_BAR; PG8_WAIT_L(0); PG8_MMA(0, 1, At, B1); PG8_BAR;
            PG8_LDA(At, 1, 1); PG8_STAGE(PG8_SA(1, 0), a3, voffA);
            PG8_BAR; PG8_WAIT_L(0); PG8_MMA(1, 0, At, B0); PG8_BAR; PG8_SCHED;
            PG8_STAGE(PG8_SB(1, 1), b3 + hstepB, voffB);
            PG8_WAIT_V(6); PG8_BAR; PG8_MMA(1, 1, At, B1); PG8_BAR;
            }
        }
        if constexpr (ALIGN_EPI) { if (wr == 0) PG8_BAR; }
        if constexpr (!Epi::AFTER_DRAIN) { E(acc, cur, wr, wc, fr, fq); S.done(cur); }
        if (!has_next) break;
#pragma unroll
        for (int a = 0; a < 2; ++a)
#pragma unroll
            for (int b = 0; b < 2; ++b)
#pragma unroll
                for (int m = 0; m < 4; ++m)
#pragma unroll
                    for (int n = 0; n < 2; ++n) acc[a][b][m][n] = (f32x4){0.f, 0.f, 0.f, 0.f};
        cur = nxt; cA = nA; cB = nB; ++ui;
        if constexpr (ALIGN_EPI) { if (wr == 1) PG8_BAR; }
    }
    PG8_WAIT_V(0);
    if constexpr (!ALIGN_EPI) { if (wr == 0) PG8_BAR; }
    PG8_BAR;
#undef PG8_SA
#undef PG8_SB
#undef PG8_STAGE
#undef PG8_LDA
#undef PG8_LDB
#undef PG8_MMA
#undef PG8_WAIT_V
#undef PG8_WAIT_L
#undef PG8_BAR
#undef PG8_SCHED
}
}

constexpr int NWAVES = 8, NTHR = 512;
constexpr int D = 4096, BATCH = 4, SEQ = 2048, NSMP = 8, MPR = BATCH * SEQ  , MV = MPR + NSMP  , MP = 8448  ;
constexpr int SSM_INNER = 3072, XBC = 5120, NH = 48, HP = 64, NG = 8, HPG = 6, NST = 128, CHUNK = 128, NCHUNK = SEQ / CHUNK;
constexpr int AIN_N = 9472;
constexpr int ZX_Z = 0, ZX_XBC = 3072, ZX_QM = 8192, ZX_DT = 9216;
constexpr int AIN_SRC = 9264;
constexpr int DFF = 11008, UP_N = 2 * DFF;
constexpr int KV_COLS = 6144, KVQ_N = 10240;
constexpr int KQ_Q = 6144, KQ_QM = 9216;
constexpr int PF = 11072, P2 = 2112;
constexpr int PD = 4160;
constexpr int MEMR = BATCH * 256;
constexpr int PAST_LEN = 16384;
constexpr float EPS = 1e-6f;

constexpr size_t O_YP = 0, O_YS = O_YP + (size_t)MPR * D, O_SSMP = O_YS + (size_t)NSMP * D, O_SSMS = O_SSMP + (size_t)BATCH * NH * HP * NST,
    O_CONVP = O_SSMS + (size_t)NSMP * NH * HP * NST, O_CONVS = O_CONVP + (size_t)BATCH * 3 * XBC, O_FFNP = O_CONVS + (size_t)NSMP * 3 * XBC,
    O_FFNS = O_FFNP + (size_t)2 * BATCH * 2 * DFF, O_MEMKV = O_FFNS + (size_t)2 * NSMP * 2 * DFF, O_WK0P = O_MEMKV + (size_t)2 * BATCH * 256 * 2048,
    O_WK1P = O_WK0P + (size_t)BATCH * 128 * 2048, O_WK2P = O_WK1P + (size_t)BATCH * 512 * 2048, O_WK0S = O_WK2P + (size_t)BATCH * 2048 * 2048,
    O_WK1S = O_WK0S + (size_t)NSMP * 2048, O_WK2S = O_WK1S + (size_t)NSMP * 2048, O_END = O_WK2S + (size_t)NSMP * 2048;

constexpr size_t al(size_t x) { return (x + 1048575) & ~(size_t)1048575; }
constexpr size_t WS_CTL = 0, CTL_ZERO_BYTES = 1048576;
constexpr size_t WS_WINA = 1048576;
constexpr size_t WS_WOUTA = WS_WINA + al((size_t)AIN_N * PD * 2);
constexpr size_t WS_WUP = WS_WOUTA + al((size_t)D * PD * 2);
constexpr size_t WS_WDOWN = WS_WUP + al((size_t)2 * UP_N * PD * 2);
constexpr size_t WS_WKVQ = WS_WDOWN + al((size_t)2 * D * PF * 2);
constexpr size_t WS_WOUTB = WS_WKVQ + al((size_t)KVQ_N * PD * 2);
constexpr size_t WS_WMEM = WS_WOUTB + al((size_t)D * P2 * 2);
constexpr size_t WS_XB = WS_WMEM + al((size_t)4096 * PD * 2);
constexpr size_t WS_SSQ = WS_XB + al((size_t)MP * PD * 2);
constexpr size_t WS_ZX = WS_SSQ + al((size_t)MP * 64 * 4);
constexpr size_t WS_XC = WS_ZX + al((size_t)MP * AIN_N * 2);
constexpr size_t WS_DTV = WS_XC + al((size_t)MP * XBC * 2);
constexpr size_t WS_CUM = WS_DTV + al((size_t)MP * NH * 4);
constexpr size_t WS_SST = WS_CUM + al((size_t)MP * NH * 4);
constexpr size_t WS_HB = WS_SST + al((size_t)BATCH * NCHUNK * NH * HP * NST * 4);
constexpr size_t WS_DEC = WS_HB + al((size_t)BATCH * NCHUNK * NH * HP * NST * 2);
constexpr size_t WS_MIX = WS_DEC + al((size_t)BATCH * NCHUNK * NH * 4);
constexpr size_t WS_GU = WS_MIX + al((size_t)MP * PD * 2);
constexpr size_t WS_H = WS_GU + al((size_t)MP * UP_N * 2);
constexpr size_t WS_KVQ = WS_H + al((size_t)MP * PF * 2);
constexpr size_t WS_KS = WS_KVQ + al((size_t)MP * KVQ_N * 2);
constexpr size_t WS_VT = WS_KS + al((size_t)3 * 65536 * 128 * 2);
constexpr size_t WS_QS = WS_VT + al((size_t)3 * 65536 * 128 * 2);
constexpr size_t WS_OG = WS_QS + al((size_t)3 * 65536 * 128 * 2);
constexpr size_t WS_LSE = WS_OG + al((size_t)3 * MPR * 1024 * 2);
constexpr size_t WS_MIX2 = WS_LSE + al((size_t)3 * MPR * 8 * 4);
constexpr size_t WS_MEMB = WS_MIX2 + al((size_t)MP * P2 * 2);
constexpr size_t WS_MSSQ = WS_MEMB + al((size_t)MEMR * PD * 2);
constexpr size_t WS_MRAW = WS_MSSQ + al((size_t)MEMR * 64 * 4);
constexpr size_t WS_MK = WS_MRAW + al((size_t)MEMR * 4096 * 2);
constexpr size_t WS_MVT = WS_MK + al((size_t)2 * 16 * 65536 * 2);
constexpr size_t WS_ROPE = WS_MVT + al((size_t)2 * 16 * 65536 * 2);
constexpr size_t WS_SQ = WS_ROPE + al((size_t)2049 * 32 * 4);
constexpr size_t WS_SSQS = WS_SQ + al((size_t)NSMP * 3072 * 4);
constexpr size_t WS_TAIL = WS_SSQS + al((size_t)NSMP * 256 * 4);
constexpr size_t WS_HEADG = WS_TAIL + al((size_t)64 * DFF * 4), WS_HEADU = WS_HEADG + al((size_t)64 * DFF * 4);
constexpr size_t WS_END = WS_HEADU + al((size_t)64 * DFF * 4);

constexpr int CW_TMO = 0, CW_CODE = 1, CW_BAR = 4096;

constexpr int RING_OFF = 0, RING_BYTES = 131072;
constexpr int LDS_BYTES = 147456;
constexpr int MISC_OFF = LDS_BYTES - 256;

#define GAS __attribute__((address_space(1)))
#define LAS __attribute__((address_space(3)))
typedef unsigned short bf16;
typedef unsigned v4u __attribute__((ext_vector_type(4)));
typedef unsigned v2u __attribute__((ext_vector_type(2)));
typedef float f32x4 __attribute__((ext_vector_type(4)));
typedef float f32x2 __attribute__((ext_vector_type(2)));
typedef short bf16x8 __attribute__((ext_vector_type(8)));
typedef short bf16x4 __attribute__((ext_vector_type(4)));
typedef GAS unsigned gu32;
#define RLX_AGENT __ATOMIC_RELAXED, __HIP_MEMORY_SCOPE_AGENT
#define LDS_WAIT() asm volatile("s_waitcnt lgkmcnt(0)" ::: "memory")
#define VM_WAIT() asm volatile("s_waitcnt vmcnt(0)" ::: "memory")
typedef __bf16 bf16x2_hw __attribute__((ext_vector_type(2)));
__device__ __forceinline__ unsigned pk2(float lo, float hi) { const f32x2 v = {lo, hi}; return __builtin_bit_cast(unsigned, __builtin_convertvector(v, bf16x2_hw)); }
__device__ __forceinline__ unsigned f2bf(float f) { return pk2(f, 0.f) & 0xffffu; }
__device__ __forceinline__ float bflo(unsigned u) { return __builtin_bit_cast(float, u << 16); }
__device__ __forceinline__ float bfhi(unsigned u) { return __builtin_bit_cast(float, u & 0xffff0000u); }
__device__ __forceinline__ float bf2f(bf16 h) { return __builtin_bit_cast(float, (unsigned)h << 16); }
__device__ __forceinline__ float siluf(float x) { return x * __builtin_amdgcn_rcpf(1.0f + __expf(-x)); }
__device__ __forceinline__ float wave_sum(float v) {
#pragma unroll
    for (int o = 1; o < 64; o <<= 1) v += __shfl_xor(v, o);
    return v;
}
__device__ __forceinline__ float wave_max(float v) {
#pragma unroll
    for (int o = 1; o < 64; o <<= 1) v = fmaxf(v, __shfl_xor(v, o));
    return v;
}

#define XB_TMO      128
#define XB_XCNT(j)  (256  + 64 * (j))
#define XB_XSUB(j)  (1280 + 64 * (j))
#define XB_XGEN(j)  (2304 + 64 * (j))
#define XB_TOP      3328
#define XB_TOPGEN   3392
#define XCD_BAR_WORDS 3456
#define XB_SPIN_CAP (1u << 18)
__device__ __forceinline__ unsigned xb_ld(unsigned* p)              { return __hip_atomic_load(p, __ATOMIC_RELAXED, __HIP_MEMORY_SCOPE_AGENT); }
__device__ __forceinline__ unsigned xb_add(unsigned* p, unsigned v) { return __hip_atomic_fetch_add(p, v, __ATOMIC_RELAXED, __HIP_MEMORY_SCOPE_AGENT); }
__device__ __forceinline__ unsigned xb_xcc_id() { return (unsigned)__builtin_amdgcn_s_getreg((3 << 11) | 20) & 0xFu; }
#define XB_SPIN(cond, bar) do { unsigned _sp = 0; while (cond) { __builtin_amdgcn_s_sleep(1); \
    if ((++_sp & 255u) == 0u) { if (xb_ld(&(bar)[XB_TMO])) break; if (_sp > XB_SPIN_CAP) { atomicAdd(&(bar)[XB_TMO], 1u); break; } } } } while (0)
struct XcdBarrier { unsigned* bar; unsigned x; volatile LAS unsigned* st; };
__device__ __forceinline__ XcdBarrier xcd_barrier_post(unsigned* bar, volatile LAS unsigned* st, bool t0) {
    XcdBarrier b; b.bar = bar; b.x = xb_xcc_id(); b.st = st;
    if (t0) (void)xb_add(&bar[XB_XCNT(b.x)], 1u);
    return b;
}
__device__ __forceinline__ void xcd_barrier_complete(unsigned* bar, unsigned x, unsigned& nloc, unsigned& nx) {
    const unsigned G = gridDim.x * gridDim.y * gridDim.z;
    unsigned sum, cnt, mine, sp = 0u;
    for (;;) {
        sum = 0u; cnt = 0u; mine = 0u;
#pragma unroll
        for (unsigned j = 0; j < 16; ++j) { const unsigned c = xb_ld(&bar[XB_XCNT(j)]); sum += c; cnt += (c > 0u) ? 1u : 0u; mine = (j == x) ? c : mine; }
        if (sum == G) break;
        __builtin_amdgcn_s_sleep(1);
        if ((++sp & 255u) == 0u) { if (xb_ld(&bar[XB_TMO])) break; if (sp > XB_SPIN_CAP) { atomicAdd(&bar[XB_TMO], 1u); break; } }
    }
    nloc = mine > 0u ? mine : 1u; nx = cnt > 0u ? cnt : 1u;
}
__device__ __forceinline__ void xcd_barrier(const XcdBarrier& b, bool t0) {
    asm volatile("s_waitcnt vmcnt(0)" ::: "memory");
    __syncthreads();
    if (t0) {
        unsigned* bar = b.bar;
        __builtin_amdgcn_s_waitcnt(0);
        unsigned nloc = b.st[0], nx = b.st[1];
        if (nloc == 0u) { xcd_barrier_complete(bar, b.x, nloc, nx); b.st[0] = nloc; b.st[1] = nx; }
        const unsigned old = xb_add(&bar[XB_XSUB(b.x)], 1u);
        const unsigned gen = old / nloc;
        if (old + 1u == (gen + 1u) * nloc) {
            __builtin_amdgcn_fence(__ATOMIC_RELEASE, "agent");
            asm volatile("s_waitcnt vmcnt(0)" ::: "memory");
            const unsigned og = xb_add(&bar[XB_TOP], 1u);
            const unsigned tg = og / nx;
            if (og + 1u == (tg + 1u) * nx) xb_add(&bar[XB_TOPGEN], 1u);
            else XB_SPIN(xb_ld(&bar[XB_TOPGEN]) == tg, bar);
            __builtin_amdgcn_fence(__ATOMIC_ACQUIRE, "agent");
            xb_add(&bar[XB_XGEN(b.x)], 1u);
            asm volatile("s_waitcnt vmcnt(0)" ::: "memory");
        } else {
            XB_SPIN(xb_ld(&bar[XB_XGEN(b.x)]) == gen, bar);
            __builtin_amdgcn_fence(__ATOMIC_ACQUIRE, "agent");
            asm volatile("s_waitcnt vmcnt(0)" ::: "memory");
        }
    }
    __syncthreads();
}

struct Args { const float* in[34]; float* out; unsigned char* ws; int ph_lo, ph_hi; };
struct Frame {
    LAS unsigned char* lds;
    int tid, lane, wave, vcu, G;
    const float* const* in;
    float* out; unsigned char* ws;
};
#define WSP(T, off) ((T*)(F.ws + (off)))
#define INP(k) (F.in[k])
enum { I_XP = 0, I_XS, I_SSM, I_SSMCONV, I_FFNCONV, I_CMEM, I_WIN0, I_WIN1, I_WIN2, I_MEMP, I_GMIX, I_WINA, I_WCONVA, I_BCONVA, I_DTBIAS, I_ALOG, I_DSKIP, I_GSSM, I_WOUTA,
       I_GKV, I_WKV, I_GKDIL, I_WINB, I_GQDIL, I_WOUTB, I_GMEM, I_WMEMKV, I_GMEMQ, I_GMEMK, I_GFFN, I_WUP, I_WFCONV, I_BFCONV, I_WDOWN };

struct TItem { const float* W; const float* g; bf16* WT; int ldw, Nsrc, sc, valid, d0, k0; };
__device__ __forceinline__ void p0_item_load(const TItem& t, f32x4 (&v)[16], int lane) {
    const int n4 = lane & 15, kr = lane >> 4;
#pragma unroll
    for (int i = 0; i < 16; ++i) v[i] = (4 * n4 < t.valid) ? __builtin_nontemporal_load((const GAS f32x4*)(t.W + (size_t)(t.k0 + 4 * i + kr) * t.Nsrc + t.sc + 4 * n4)) : (f32x4){0.f, 0.f, 0.f, 0.f};
}
__device__ __forceinline__ void p0_item_store(const TItem& t, const f32x4 (&v)[16], LAS float* scr, int lane) {
    const int n4 = lane & 15, kr = lane >> 4;
#pragma unroll
    for (int i = 0; i < 16; ++i) { const int kk = 4 * i + kr; *(LAS f32x4*)(scr + kk * 68 + 4 * (n4 ^ ((kk >> 3) & 7))) = v[i]; }
    if (t.g) scr[64 * 68 + lane] = t.g[t.k0 + lane];
    LDS_WAIT(); asm volatile("" ::: "memory");
    const int c = lane & 7;
    if (t.g) {
        float gg[8];
#pragma unroll
        for (int j = 0; j < 8; ++j) gg[j] = scr[64 * 68 + 8 * c + j];
#pragma unroll
        for (int j = 0; j < 8; ++j) { const int n = (lane >> 3) + 8 * j; const LAS float* sp = scr + (8 * c) * 68 + (n ^ (4 * c));
            v4u o; o.x = pg8::cvt_pk_bf16(sp[0 * 68] * gg[0], sp[1 * 68] * gg[1]); o.y = pg8::cvt_pk_bf16(sp[2 * 68] * gg[2], sp[3 * 68] * gg[3]); o.z = pg8::cvt_pk_bf16(sp[4 * 68] * gg[4], sp[5 * 68] * gg[5]); o.w = pg8::cvt_pk_bf16(sp[6 * 68] * gg[6], sp[7 * 68] * gg[7]);
            *(GAS v4u*)(t.WT + (size_t)(t.d0 + n) * t.ldw + t.k0 + 8 * c) = o; }
    } else {
#pragma unroll
        for (int j = 0; j < 8; ++j) { const int n = (lane >> 3) + 8 * j; const LAS float* sp = scr + (8 * c) * 68 + (n ^ (4 * c));
            v4u o; o.x = pg8::cvt_pk_bf16(sp[0 * 68], sp[1 * 68]); o.y = pg8::cvt_pk_bf16(sp[2 * 68], sp[3 * 68]); o.z = pg8::cvt_pk_bf16(sp[4 * 68], sp[5 * 68]); o.w = pg8::cvt_pk_bf16(sp[6 * 68], sp[7 * 68]);
            *(GAS v4u*)(t.WT + (size_t)(t.d0 + n) * t.ldw + t.k0 + 8 * c) = o; }
    }
    LDS_WAIT(); asm volatile("" ::: "memory");
}
__device__ __forceinline__ void p0_row_load(Frame& F, const float* xrow, f32x4 (&v)[16]) {
    const GAS f32x4* xr = (const GAS f32x4*)xrow + 2 * F.lane;
#pragma unroll
    for (int j = 0; j < 8; ++j) { v[2 * j] = __builtin_nontemporal_load(xr + 128 * j); v[2 * j + 1] = __builtin_nontemporal_load(xr + 128 * j + 1); }
}
__device__ __forceinline__ void p0_row_store(Frame& F, const f32x4 (&v)[16], bf16* orow, float* ssq) {
    GAS v4u* o16 = (GAS v4u*)orow + F.lane; float s = 0.f;
#pragma unroll
    for (int j = 0; j < 8; ++j) { const f32x4 a = v[2 * j], b = v[2 * j + 1]; s += ((a.x * a.x + a.y * a.y) + (a.z * a.z + a.w * a.w)) + ((b.x * b.x + b.y * b.y) + (b.z * b.z + b.w * b.w));
        v4u w; w.x = pk2(a.x, a.y); w.y = pk2(a.z, a.w); w.z = pk2(b.x, b.y); w.w = pk2(b.z, b.w); o16[64 * j] = w; }
    s = wave_sum(s);
    ssq[F.lane] = (F.lane == 0) ? s : 0.f;
}
constexpr int CV_KB4 = D / 64, CV_KBF = DFF / 64, CV_KB2 = 2048 / 64;
constexpr int CV_J0 = CV_KB4 * (AIN_N / 64), CV_J1 = CV_KB4 * (D / 64), CV_J2 = CV_KB4 * (UP_N / 64), CV_J4 = CV_KBF * (D / 64), CV_J6 = CV_KB4 * (KV_COLS / 64), CV_J7 = CV_KB4 * (D / 64), CV_J8 = CV_KB2 * (D / 64), CV_J9 = CV_KB4 * (2048 / 64);
constexpr int CV_O1 = CV_J0, CV_O2 = CV_O1 + CV_J1, CV_O3 = CV_O2 + CV_J2, CV_O4 = CV_O3 + CV_J2, CV_O5 = CV_O4 + CV_J4, CV_O6 = CV_O5 + CV_J4, CV_O7 = CV_O6 + CV_J6, CV_O8 = CV_O7 + CV_J7, CV_O9 = CV_O8 + CV_J8, CV_END = CV_O9 + 2 * CV_J9;
__device__ __forceinline__ TItem p0_decode(Frame& F, int it) {
    constexpr int J0 = CV_J0, J1 = CV_J1, J2 = CV_J2, J4 = CV_J4, J6 = CV_J6, J7 = CV_J7, J8 = CV_J8, J9 = CV_J9;
    TItem t; int r = it;
    if (r < J0) {
        const int nblk = AIN_N / 64, kb = r / nblk, nb = r % nblk, d0 = nb * 64; int sc, valid = 64;
        if (d0 < ZX_QM) sc = d0; else if (d0 < ZX_DT) sc = 8240 + (d0 - ZX_QM); else if (d0 == ZX_DT) { sc = 8192; valid = 48; } else { sc = 0; valid = 0; }
        t = TItem{INP(I_WINA), INP(I_GMIX), WSP(bf16, WS_WINA), PD, AIN_SRC, sc, valid, d0, kb * 64}; return t; } r -= J0;
    if (r < J1) { const int nblk = D / 64, kb = r / nblk, nb = r % nblk; t = TItem{INP(I_WOUTA), nullptr, WSP(bf16, WS_WOUTA), PD, D, nb * 64, 64, nb * 64, kb * 64}; return t; } r -= J1;
    if (r < 2 * J2) { const int l = r / J2; r -= l * J2;
        const int nblk = UP_N / 64, kb = r / nblk, nb = r % nblk, d0 = nb * 64, j = d0 >> 8, w = d0 & 255; const int sc = (w < 128) ? (128 * j + w) : (DFF + 128 * j + (w - 128));
        t = TItem{INP(I_WUP) + (size_t)l * D * UP_N, INP(I_GFFN) + l * D, WSP(bf16, WS_WUP) + (size_t)l * UP_N * PD, PD, UP_N, sc, 64, d0, kb * 64}; return t; } r -= 2 * J2;
    if (r < 2 * J4) { const int l = r / J4; r -= l * J4; const int nblk = D / 64, kb = r / nblk, nb = r % nblk;
        t = TItem{INP(I_WDOWN) + (size_t)l * DFF * D, nullptr, WSP(bf16, WS_WDOWN) + (size_t)l * D * PF, PF, D, nb * 64, 64, nb * 64, kb * 64}; return t; } r -= 2 * J4;
    if (r < J6) { const int nblk = KV_COLS / 64, kb = r / nblk, nb = r % nblk; t = TItem{INP(I_WKV), INP(I_GKV), WSP(bf16, WS_WKVQ), PD, KV_COLS, nb * 64, 64, nb * 64, kb * 64}; return t; } r -= J6;
    if (r < J7) { const int nblk = D / 64, kb = r / nblk, nb = r % nblk; t = TItem{INP(I_WINB), INP(I_GMIX) + D, WSP(bf16, WS_WKVQ), PD, D, nb * 64, 64, KV_COLS + nb * 64, kb * 64}; return t; } r -= J7;
    if (r < J8) { const int nblk = D / 64, kb = r / nblk, nb = r % nblk; t = TItem{INP(I_WOUTB), nullptr, WSP(bf16, WS_WOUTB), P2, D, nb * 64, 64, nb * 64, kb * 64}; return t; } r -= J8;
    { const int l = r / J9; r -= l * J9; const int nblk = 2048 / 64, kb = r / nblk, nb = r % nblk;
        t = TItem{INP(I_WMEMKV) + (size_t)l * D * 2048, INP(I_GMEM) + l * D, WSP(bf16, WS_WMEM), PD, 2048, nb * 64, 64, l * 2048 + nb * 64, kb * 64}; return t; }
}
__device__ __forceinline__ void convert_range(Frame& F, int lo, int hi, int widx, int nw) {
    LAS float* scr = (LAS float*)(F.lds + RING_OFF + F.wave * 17920);
    const int gw = lo + widx * NWAVES + F.wave, NGW = nw * NWAVES;
    __syncthreads();
    f32x4 va[16], vb[16]; TItem ta, tb;
    if (gw < hi) { ta = p0_decode(F, gw); p0_item_load(ta, va, F.lane); }
    for (int it = gw; it < hi; it += 2 * NGW) {
        const bool hb = it + NGW < hi, ha = it + 2 * NGW < hi;
        if (hb) { tb = p0_decode(F, it + NGW); p0_item_load(tb, vb, F.lane); }
        p0_item_store(ta, va, scr, F.lane);
        if (ha) { ta = p0_decode(F, it + 2 * NGW); p0_item_load(ta, va, F.lane); }
        if (hb) p0_item_store(tb, vb, scr, F.lane);
    }
    __syncthreads();
}
#define CONVERT_PRE(lo, hi)  do { REFRESH(); if ((blockIdx.x & 1) == 0) convert_range(F, lo, (lo) + ((hi) - (lo)) / 2, (int)(blockIdx.x >> 1), (F.G + 1) / 2); REFRESH(); } while (0)
#define CONVERT_POST(lo, hi) do { REFRESH(); if ((blockIdx.x & 1) == 1) convert_range(F, (lo) + ((hi) - (lo)) / 2, hi, (int)(blockIdx.x >> 1), F.G / 2); REFRESH(); } while (0)
__device__ __forceinline__ void p0_prologue(Frame& F) {
    const int gw = F.vcu * NWAVES + F.wave, NGW = F.G * NWAVES;
    convert_range(F, 0, CV_O1, F.vcu, F.G);
    convert_range(F, CV_O9, CV_END, F.vcu, F.G);
    {
      auto src = [&](int m) -> const float* { return (m < MPR) ? INP(I_XP) + (size_t)m * D : (m < MV ? INP(I_XS) + (size_t)(m - MPR) * D : INP(I_MEMP) + (size_t)(m - MV) * D); };
      auto put = [&](int m, const f32x4 (&v)[16]) {
          if (m < MPR) p0_row_store(F, v, WSP(bf16, WS_XB) + (size_t)m * PD, WSP(float, WS_SSQ) + (size_t)m * 64);
          else if (m < MV) { float* q = WSP(float, WS_SSQS) + (size_t)(m - MPR) * 256; p0_row_store(F, v, WSP(bf16, WS_XB) + (size_t)m * PD, q); q[64 + F.lane] = 0.f; q[128 + F.lane] = 0.f; q[192 + F.lane] = 0.f; }
          else p0_row_store(F, v, WSP(bf16, WS_MEMB) + (size_t)(m - MV) * PD, WSP(float, WS_MSSQ) + (size_t)(m - MV) * 64); };
      f32x4 va[16], vb[16];
      if (gw < MV + MEMR) p0_row_load(F, src(gw), va);
      for (int m = gw; m < MV + MEMR; m += 2 * NGW) {
          const bool hb = m + NGW < MV + MEMR, ha = m + 2 * NGW < MV + MEMR;
          if (hb) p0_row_load(F, src(m + NGW), vb);
          put(m, va);
          if (ha) p0_row_load(F, src(m + 2 * NGW), va);
          if (hb) put(m + NGW, vb);
      }
    }
    { const int gt = F.vcu * NTHR + F.tid, NT = F.G * NTHR;
      for (int i = gt; i < 2049 * 16; i += NT) { const int p = i >> 4, k = i & 15; const float invf = expf(-(2.0f * (float)k / 32.0f) * 13.122363377404328f);
          const float ang = (float)(p < 2048 ? p : PAST_LEN) * invf; WSP(float, WS_ROPE)[p * 32 + k] = cosf(ang); WSP(float, WS_ROPE)[p * 32 + 16 + k] = sinf(ang); }
    }
}

__device__ __forceinline__ void unpack8(const v4u r, float (&x)[8]) { x[0] = bflo(r.x); x[1] = bfhi(r.x); x[2] = bflo(r.y); x[3] = bfhi(r.y); x[4] = bflo(r.z); x[5] = bfhi(r.z); x[6] = bflo(r.w); x[7] = bfhi(r.w); }
__device__ __forceinline__ v4u pack8(const float (&x)[8]) { v4u o; o.x = pk2(x[0], x[1]); o.y = pk2(x[2], x[3]); o.z = pk2(x[4], x[5]); o.w = pk2(x[6], x[7]); return o; }
__device__ __forceinline__ void ld8f(const float* p, float (&x)[8]) { const f32x4 a = *(const f32x4*)p, b = *(const f32x4*)(p + 4); x[0] = a.x; x[1] = a.y; x[2] = a.z; x[3] = a.w; x[4] = b.x; x[5] = b.y; x[6] = b.z; x[7] = b.w; }
__device__ __forceinline__ void st8f(float* p, const float (&x)[8]) { *(f32x4*)p = (f32x4){x[0], x[1], x[2], x[3]}; *(f32x4*)(p + 4) = (f32x4){x[4], x[5], x[6], x[7]}; }

__device__ __forceinline__ void e1_conv(Frame& F) {
    const int gt = F.vcu * NTHR + F.tid, NT = F.G * NTHR;
    const bf16* ZX = WSP(bf16, WS_ZX); bf16* XC = WSP(bf16, WS_XC);
    const float* wcv = INP(I_WCONVA); const float* bcv = INP(I_BCONVA);
    for (int it = gt; it < (MPR / 32) * (XBC / 8); it += NT) {
        const int rb = it / (XBC / 8), cg = it % (XBC / 8), ch = cg * 8, b = rb >> 6, t0 = (rb & 63) * 32, row0 = b * SEQ + t0;
        float w0[8], w1[8], w2[8], w3[8], bb[8], p0[8], p1[8], p2[8];
        ld8f(wcv + ch, w0); ld8f(wcv + XBC + ch, w1); ld8f(wcv + 2 * XBC + ch, w2); ld8f(wcv + 3 * XBC + ch, w3); ld8f(bcv + ch, bb);
        if (t0 > 0) { unpack8(*(const GAS v4u*)(ZX + (size_t)(row0 - 3) * AIN_N + ZX_XBC + ch), p0); unpack8(*(const GAS v4u*)(ZX + (size_t)(row0 - 2) * AIN_N + ZX_XBC + ch), p1); unpack8(*(const GAS v4u*)(ZX + (size_t)(row0 - 1) * AIN_N + ZX_XBC + ch), p2); }
        else {
#pragma unroll
            for (int j = 0; j < 8; ++j) { p0[j] = 0.f; p1[j] = 0.f; p2[j] = 0.f; } }
#pragma unroll 1
        for (int r0 = 0; r0 < 32; r0 += 8) {
            v4u rw[8];
#pragma unroll
            for (int k = 0; k < 8; ++k) rw[k] = *(const GAS v4u*)(ZX + (size_t)(row0 + r0 + k) * AIN_N + ZX_XBC + ch);
#pragma unroll
            for (int k = 0; k < 8; ++k) { const int r = r0 + k;
                float x[8], y[8]; unpack8(rw[k], x);
#pragma unroll
                for (int j = 0; j < 8; ++j) y[j] = siluf(bb[j] + w0[j] * p0[j] + w1[j] * p1[j] + w2[j] * p2[j] + w3[j] * x[j]);
                *(GAS v4u*)(XC + (size_t)(row0 + r) * XBC + ch) = pack8(y);
                if (t0 == SEQ - 32 && r >= 29) st8f(F.out + O_CONVP + (size_t)(b * 3 + (r - 29)) * XBC + ch, x);
#pragma unroll
                for (int j = 0; j < 8; ++j) { p0[j] = p1[j]; p1[j] = p2[j]; p2[j] = x[j]; } }
        }
    }
    for (int it = gt; it < NSMP * (XBC / 8); it += NT) {
        const int b = it / (XBC / 8), ch = (it % (XBC / 8)) * 8, row = MPR + b;
        float w0[8], w1[8], w2[8], w3[8], bb[8], p0[8], p1[8], p2[8], x[8], y[8];
        ld8f(wcv + ch, w0); ld8f(wcv + XBC + ch, w1); ld8f(wcv + 2 * XBC + ch, w2); ld8f(wcv + 3 * XBC + ch, w3); ld8f(bcv + ch, bb);
        const float* st = INP(I_SSMCONV) + (size_t)b * 3 * XBC + ch; ld8f(st, p0); ld8f(st + XBC, p1); ld8f(st + 2 * XBC, p2);
        unpack8(*(const GAS v4u*)(ZX + (size_t)row * AIN_N + ZX_XBC + ch), x);
#pragma unroll
        for (int j = 0; j < 8; ++j) y[j] = siluf(bb[j] + w0[j] * p0[j] + w1[j] * p1[j] + w2[j] * p2[j] + w3[j] * x[j]);
        *(GAS v4u*)(XC + (size_t)row * XBC + ch) = pack8(y);
        float* cs = F.out + O_CONVS + (size_t)b * 3 * XBC + ch; st8f(cs, p1); st8f(cs + XBC, p2); st8f(cs + 2 * XBC, x);
    }
}
__device__ __forceinline__ float softplusf(float v) { return fmaxf(v, 0.f) + log1pf(expf(-fabsf(v))); }
__device__ __forceinline__ void e1_dt(Frame& F) {
    const int gw = F.vcu * NWAVES + F.wave, NGW = F.G * NWAVES;
    const bf16* ZX = WSP(bf16, WS_ZX); float* DTV = WSP(float, WS_DTV); float* CUM = WSP(float, WS_CUM);
    for (int it = gw; it < BATCH * NCHUNK * NH; it += NGW) {
        const int h = it % NH, row0 = (it / NH) * CHUNK, r0 = row0 + 2 * F.lane;
        const float bias = INP(I_DTBIAS)[h], an = -expf(INP(I_ALOG)[h]);
        const float d0 = softplusf(bf2f(ZX[(size_t)r0 * AIN_N + ZX_DT + h]) + bias), d1 = softplusf(bf2f(ZX[(size_t)(r0 + 1) * AIN_N + ZX_DT + h]) + bias);
        const float l0 = d0 * an, l1 = d1 * an; float x = l0 + l1;
#pragma unroll
        for (int o = 1; o < 64; o <<= 1) { const float y = __shfl_up(x, o); if (F.lane >= o) x += y; }
        DTV[(size_t)r0 * NH + h] = d0; DTV[(size_t)(r0 + 1) * NH + h] = d1; CUM[(size_t)r0 * NH + h] = x - l1; CUM[(size_t)(r0 + 1) * NH + h] = x;
    }
    const int gt = F.vcu * NTHR + F.tid;
    if (gt < NSMP * NH) { const int b = gt / NH, h = gt % NH, row = MPR + b; const float an = -expf(INP(I_ALOG)[h]);
        const float d0 = softplusf(bf2f(ZX[(size_t)row * AIN_N + ZX_DT + h]) + INP(I_DTBIAS)[h]); DTV[(size_t)row * NH + h] = d0; CUM[(size_t)row * NH + h] = d0 * an; }
}
__device__ __forceinline__ void e1_memkv(Frame& F) {
    const int gw = F.vcu * NWAVES + F.wave, NGW = F.G * NWAVES;
    const bf16* MRAW = WSP(bf16, WS_MRAW); bf16* MK = WSP(bf16, WS_MK); bf16* MVT = WSP(bf16, WS_MVT);
    for (int it0 = gw; it0 < MEMR * 8; it0 += 2 * NGW) {
        v2u krv[2], vrv[2]; f32x4 gv[2];
#pragma unroll
        for (int jj = 0; jj < 2; ++jj) { const int it = it0 + jj * NGW; if (it < MEMR * 8) { const int row = it >> 3, l = (it >> 2) & 1, h = it & 3, d = 4 * F.lane;
            krv[jj] = *(const GAS v2u*)(MRAW + (size_t)row * 4096 + l * 2048 + h * 256 + d); vrv[jj] = *(const GAS v2u*)(MRAW + (size_t)row * 4096 + l * 2048 + 1024 + h * 256 + d); gv[jj] = *(const f32x4*)(INP(I_GMEMK) + l * 256 + d); } }
#pragma unroll
        for (int jj = 0; jj < 2; ++jj) { const int it = it0 + jj * NGW; if (it < MEMR * 8) {
        const int row = it >> 3, l = (it >> 2) & 1, h = it & 3, b = row >> 8, m = row & 255, d = 4 * F.lane;
        const v2u kr = krv[jj], vr = vrv[jj];
        float k0 = bflo(kr.x), k1 = bfhi(kr.x), k2 = bflo(kr.y), k3 = bfhi(kr.y);
        const float ss = wave_sum((k0 * k0 + k1 * k1) + (k2 * k2 + k3 * k3)), rs = 1.0f / sqrtf(ss * (1.0f / 256.0f) + EPS);
        const f32x4 g = gv[jj];
        k0 *= rs * g.x; k1 *= rs * g.y; k2 *= rs * g.z; k3 *= rs * g.w;
        float* o = F.out + O_MEMKV + ((size_t)((l * BATCH + b) * 256 + m) * 2) * 1024 + h * 256 + d;
        *(f32x4*)o = (f32x4){k0, k1, k2, k3}; *(f32x4*)(o + 1024) = (f32x4){bflo(vr.x), bfhi(vr.x), bflo(vr.y), bfhi(vr.y)};
        const size_t hb = (size_t)((l * BATCH + b) * 4 + h) * 65536;
        v2u kw; kw.x = pk2(k0, k1); kw.y = pk2(k2, k3); *(GAS v2u*)(MK + hb + (size_t)m * 256 + d) = kw;
        MVT[hb + (size_t)(d + 0) * 256 + m] = (bf16)(vr.x & 0xffffu); MVT[hb + (size_t)(d + 1) * 256 + m] = (bf16)(vr.x >> 16);
        MVT[hb + (size_t)(d + 2) * 256 + m] = (bf16)(vr.y & 0xffffu); MVT[hb + (size_t)(d + 3) * 256 + m] = (bf16)(vr.y >> 16);
        } }
    }
}

typedef short v4i16_t __attribute__((ext_vector_type(4)));
#define MFMA16(a, b, c) __builtin_amdgcn_mfma_f32_16x16x32_bf16((a), (b), (c), 0, 0, 0)
__device__ __forceinline__ bf16x4 lds_tr(const LAS bf16* p) { return __builtin_bit_cast(bf16x4, __builtin_amdgcn_ds_read_tr16_b64_v4i16((LAS v4i16_t*)p)); }
__device__ __forceinline__ bf16x8 tr_frag(const LAS bf16* T, int ld, int kA, int kB, int c0, int lane) {
    const int q = (lane & 15) >> 2, p = lane & 3;
    const bf16x4 lo = lds_tr(T + (kA + q) * ld + c0 + 4 * p), hi = lds_tr(T + (kB + q) * ld + c0 + 4 * p);
    return (bf16x8){lo[0], lo[1], lo[2], lo[3], hi[0], hi[1], hi[2], hi[3]};
}
__device__ __forceinline__ bf16x8 cat4(bf16x4 lo, bf16x4 hi) { return (bf16x8){lo[0], lo[1], lo[2], lo[3], hi[0], hi[1], hi[2], hi[3]}; }
__device__ __forceinline__ bf16x8 pack_p(const f32x4 a, const f32x4 b) { v4u o; o.x = pk2(a[0], a[1]); o.y = pk2(a[2], a[3]); o.z = pk2(b[0], b[1]); o.w = pk2(b[2], b[3]); return __builtin_bit_cast(bf16x8, o); }
__device__ __forceinline__ int vgpr_i(int x) { asm volatile("" : "+v"(x)); return x; }

__device__ __forceinline__ void mem_attn_prompt(Frame& F, const bf16* Qb, int ldq, const float* gq, const bf16* MKl, const bf16* MVTl, bf16* Ob, int ldo, int cu0 = 0) {
    LAS unsigned char* T = F.lds;
    const int tid = F.tid, lane = F.lane, w = F.wave, r16 = lane & 15, fq = lane >> 4;
    for (int u = F.vcu - cu0; u >= 0 && u < BATCH * 4 * 16; u += F.G - cu0) {
        const int qb = u & 15, h = (u >> 4) & 3, b = u >> 6, row = b * SEQ + qb * 128 + 16 * w + r16;
        const bf16* Kg = MKl + (size_t)(b * 4 + h) * 65536; const bf16* Vg = MVTl + (size_t)(b * 4 + h) * 65536;
        const bf16* qp = Qb + (size_t)row * ldq + 256 * h + 8 * fq;
        bf16x8 qf[8]; float ss = 0.f;
#pragma unroll
        for (int ks = 0; ks < 8; ++ks) { qf[ks] = *(const GAS bf16x8*)(qp + 32 * ks); float x[8]; unpack8(__builtin_bit_cast(v4u, qf[ks]), x);
#pragma unroll
            for (int j = 0; j < 8; ++j) ss += x[j] * x[j]; }
        ss += __shfl_xor(ss, 16); ss += __shfl_xor(ss, 32);
        const float rs = (1.0f / sqrtf(ss * (1.0f / 256.0f) + EPS)) * 0.0625f;
#pragma unroll
        for (int ks = 0; ks < 8; ++ks) { float x[8], g[8]; unpack8(__builtin_bit_cast(v4u, qf[ks]), x); ld8f(gq + 32 * ks + 8 * fq, g);
#pragma unroll
            for (int j = 0; j < 8; ++j) x[j] *= rs * g[j];
            qf[ks] = __builtin_bit_cast(bf16x8, pack8(x)); }
        v4u st[8];
#pragma unroll
        for (int j = 0; j < 8; ++j) st[j] = *(const GAS v4u*)(Kg + (size_t)(tid >> 5) * 256 + 8 * (tid & 31) + j * 4096);
        f32x4 acc[16];
#pragma unroll
        for (int half = 0; half < 2; ++half) {
            __syncthreads();
#pragma unroll
            for (int j = 0; j < 8; ++j) { const int r = tid >> 5, c = tid & 31; *(LAS v4u*)(T + r * 512 + 16 * ((c & 16) | ((c ^ r) & 15)) + j * 8192) = st[j]; }
            __syncthreads();
            if (half == 0) {
#pragma unroll
                for (int j = 0; j < 8; ++j) st[j] = *(const GAS v4u*)(Kg + (size_t)(128 + (tid >> 5)) * 256 + 8 * (tid & 31) + j * 4096);
            } else {
#pragma unroll
                for (int j = 0; j < 8; ++j) st[j] = *(const GAS v4u*)(Vg + (size_t)(tid >> 5) * 256 + 8 * (tid & 31) + j * 4096);
            }
#pragma unroll
            for (int nt = 0; nt < 8; ++nt) { f32x4 a = (f32x4){0.f, 0.f, 0.f, 0.f}; const int r = 16 * nt + r16;
#pragma unroll
                for (int ks = 0; ks < 8; ++ks) { const int c = 4 * ks + fq; const bf16x8 kf = *(const LAS bf16x8*)(T + r * 512 + 16 * ((c & 16) | ((c ^ r) & 15))); a = MFMA16(kf, qf[ks], a); }
                acc[8 * half + nt] = a; __builtin_amdgcn_sched_barrier(0); }
        }
        float mx = -INFINITY;
#pragma unroll
        for (int nt = 0; nt < 16; ++nt) mx = fmaxf(fmaxf(fmaxf(acc[nt][0], acc[nt][1]), fmaxf(acc[nt][2], acc[nt][3])), mx);
        mx = fmaxf(mx, __shfl_xor(mx, 16)); mx = fmaxf(mx, __shfl_xor(mx, 32));
        float sum = 0.f;
#pragma unroll
        for (int nt = 0; nt < 16; ++nt) {
#pragma unroll
            for (int i = 0; i < 4; ++i) { acc[nt][i] = __expf(acc[nt][i] - mx); sum += acc[nt][i]; } }
        sum += __shfl_xor(sum, 16); sum += __shfl_xor(sum, 32);
        const float inv = 1.0f / sum;
        bf16x8 pf[8];
#pragma unroll
        for (int kk = 0; kk < 8; ++kk) pf[kk] = pack_p(acc[2 * kk], acc[2 * kk + 1]);
        bf16* op = Ob + (size_t)row * ldo + 256 * h + 4 * fq;
#pragma unroll
        for (int half = 0; half < 2; ++half) {
            __syncthreads();
#pragma unroll
            for (int j = 0; j < 8; ++j) { const int r = tid >> 5, c = tid & 31; *(LAS v4u*)(T + r * 512 + 16 * ((c & 16) | ((c ^ r) & 15)) + j * 8192) = st[j]; }
            __syncthreads();
            if (half == 0) {
#pragma unroll
                for (int j = 0; j < 8; ++j) st[j] = *(const GAS v4u*)(Vg + (size_t)(128 + (tid >> 5)) * 256 + 8 * (tid & 31) + j * 4096);
            }
#pragma unroll
            for (int dt = 0; dt < 8; ++dt) { const int d = 16 * dt + r16; f32x4 o = (f32x4){0.f, 0.f, 0.f, 0.f};
#pragma unroll
                for (int kk = 0; kk < 8; ++kk) { const int c0 = 4 * kk + (fq >> 1), c1 = c0 + 2;
                    const bf16x4 lo = *(const LAS bf16x4*)(T + d * 512 + 16 * ((c0 & 16) | ((c0 ^ d) & 15)) + 8 * (fq & 1)), hi = *(const LAS bf16x4*)(T + d * 512 + 16 * ((c1 & 16) | ((c1 ^ d) & 15)) + 8 * (fq & 1));
                    o = MFMA16(cat4(lo, hi), pf[kk], o); }
                v2u wv; wv.x = pk2(o[0] * inv, o[1] * inv); wv.y = pk2(o[2] * inv, o[3] * inv); *(GAS v2u*)(op + 128 * half + 16 * dt) = wv; __builtin_amdgcn_sched_barrier(0); }
        }
    }
    __syncthreads();
}
__device__ __forceinline__ void mem_attn_sample(Frame& F, const bf16* Qb, int ldq, const float* gq, const float* cache, bf16* Ob, int ldo, int cu0) {
    LAS float* qs = (LAS float*)(F.lds + 0); LAS float* ps = qs + 256; LAS float* red = qs + 512; LAS float* part = qs + 528;
    const int tid = F.tid, lane = F.lane, w = F.wave;
    for (int u = (F.vcu + F.G - cu0 % F.G) % F.G; u < NSMP * 4; u += F.G) {
        const int b = u >> 2, h = u & 3, row = MPR + b;
        __syncthreads();
        if (w < 4) {
            const v2u qr = *(const GAS v2u*)(Qb + (size_t)row * ldq + 256 * h + 4 * lane);
            float q0 = bflo(qr.x), q1 = bfhi(qr.x), q2 = bflo(qr.y), q3 = bfhi(qr.y);
            const float rs = (1.0f / sqrtf(wave_sum((q0 * q0 + q1 * q1) + (q2 * q2 + q3 * q3)) * (1.0f / 256.0f) + EPS)) * 0.0625f;
            if (w == 0) { const f32x4 g = *(const f32x4*)(gq + 4 * lane); *(LAS f32x4*)(qs + 4 * lane) = (f32x4){q0 * rs * g.x, q1 * rs * g.y, q2 * rs * g.z, q3 * rs * g.w}; }
        }
        __syncthreads();
        const float* kb = cache + (size_t)b * 256 * 2048 + h * 256;
        { const int key = tid >> 1, hf = tid & 1; const float* kp = kb + (size_t)key * 2048 + 128 * hf; float sc = 0.f;
#pragma unroll 8
          for (int d4 = 0; d4 < 32; ++d4) { const f32x4 k = *(const f32x4*)(kp + 4 * d4); const f32x4 q = *(const LAS f32x4*)(qs + 128 * hf + 4 * d4); sc += (k.x * q.x + k.y * q.y) + (k.z * q.z + k.w * q.w); }
          sc += __shfl_xor(sc, 1);
          const float wm = wave_max(sc); if (lane == 0) red[w] = wm;
          __syncthreads();
          float mx = red[0];
#pragma unroll
          for (int k = 1; k < 8; ++k) mx = fmaxf(mx, red[k]);
          const float pr = __expf(sc - mx); if (hf == 0) ps[key] = pr;
          const float wsum = wave_sum(hf == 0 ? pr : 0.f); if (lane == 0) red[8 + w] = wsum; }
        __syncthreads();
        float den = 0.f;
#pragma unroll
        for (int k = 0; k < 8; ++k) den += red[8 + k];
        { const int d = tid & 255, kh = tid >> 8; const float* vp = kb + 1024 + d + (size_t)(128 * kh) * 2048; float o = 0.f;
#pragma unroll 16
          for (int m = 0; m < 128; ++m) o += vp[(size_t)m * 2048] * ps[128 * kh + m];
          part[tid] = o; }
        __syncthreads();
        if (tid < 256) Ob[(size_t)row * ldo + 256 * h + tid] = (bf16)f2bf((part[tid] + part[256 + tid]) / den);
    }
    __syncthreads();
}

constexpr int LDT = 136, LDX = 392;
constexpr int SSD_C = 0, SSD_B = 34816, SSD_X = 34816, SSD_CUM = 135168, SSD_XB = 69632;
__device__ __forceinline__ void copy_tile(LAS bf16* dst, int lld, const bf16* src, size_t gld, int ncol, int tid) {
    const int ppr = ncol / 8;
    v4u v[4];
#pragma unroll
    for (int j = 0; j < 4; ++j) { const int i = tid + NTHR * j, r = i / ppr, c8 = i % ppr; v[j] = *(const GAS v4u*)(src + (size_t)r * gld + 8 * c8); }
#pragma unroll
    for (int j = 0; j < 4; ++j) { const int i = tid + NTHR * j, r = i / ppr, c8 = i % ppr; *(LAS v4u*)(dst + r * lld + 8 * c8) = v[j]; }
}
constexpr int SF_C = 0, SF_B = 34816, SF_XD = 69632, SF_XW = 88064, SF_H = 106496, SF_CU = 123904, LDXS = 72;
#define SF_LOAD(c_) do { const int row0_ = (b * NCHUNK + (c_)) * CHUNK; \
            _Pragma("unroll") for (int j = 0; j < 4; ++j) { const int i = tid + NTHR * j, r = i >> 4, c8 = i & 15; cv[j] = *(const GAS v4u*)(XC + (size_t)(row0_ + r) * XBC + SSM_INNER + 1024 + 128 * g + 8 * c8); bv[j] = *(const GAS v4u*)(XC + (size_t)(row0_ + r) * XBC + SSM_INNER + 128 * g + 8 * c8); } \
            const float cl = CUM[(size_t)(row0_ + 127) * NH + vgpr_i(h)]; \
            _Pragma("unroll") for (int j = 0; j < 2; ++j) { const int i = tid + NTHR * j, r = i >> 3, c8 = i & 7; xv[j] = *(const GAS v4u*)(XC + (size_t)(row0_ + r) * XBC + 64 * h + 8 * c8); \
                const float dt = DTV[(size_t)(row0_ + r) * NH + vgpr_i(h)], cm = CUM[(size_t)(row0_ + r) * NH + vgpr_i(h)]; xs_sc[j] = dt; xs_sw[j] = dt * __expf(cl - cm); } \
            if (tid < 128) { cu_t = CUM[(size_t)(row0_ + tid) * NH + vgpr_i(h)]; dt_t = DTV[(size_t)(row0_ + tid) * NH + vgpr_i(h)]; } } while (0)
__device__ __forceinline__ void ssd_fused(Frame& F, int ncu) {
    LAS bf16* Cs = (LAS bf16*)(F.lds + SF_C); LAS bf16* Bs = (LAS bf16*)(F.lds + SF_B); LAS bf16* Xd = (LAS bf16*)(F.lds + SF_XD); LAS bf16* Xw = (LAS bf16*)(F.lds + SF_XW);
    LAS bf16* Hs = (LAS bf16*)(F.lds + SF_H); LAS float* CUs = (LAS float*)(F.lds + SF_CU);
    const bf16* XC = WSP(bf16, WS_XC); const bf16* ZX = WSP(bf16, WS_ZX); const float* DTV = WSP(float, WS_DTV); const float* CUM = WSP(float, WS_CUM); bf16* MIX = WSP(bf16, WS_MIX); float* SSQH = WSP(float, WS_SST);
    const int lane = F.lane, w = F.wave, r16 = lane & 15, fq = lane >> 4, tid = F.tid;
    for (int u = F.vcu; u < BATCH * NH; u += ncu) {
        const int b = u / NH, h = u % NH, g = h / HPG; const float dsk = INP(I_DSKIP)[h];
        f32x4 hreg[4];
#pragma unroll
        for (int pt = 0; pt < 4; ++pt) hreg[pt] = (f32x4){0.f, 0.f, 0.f, 0.f};
        v4u cv[4], bv[4], xv[2]; float xs_sc[2], xs_sw[2], cu_t = 0.f, dt_t = 0.f;
        SF_LOAD(0);
#pragma unroll 1
        for (int c = 0; c < NCHUNK; ++c) {
            const int row0 = (b * NCHUNK + c) * CHUNK;
            __syncthreads();
#pragma unroll
            for (int j = 0; j < 4; ++j) { const int i = tid + NTHR * j, r = i >> 4, c8 = i & 15; *(LAS v4u*)(Cs + r * LDT + 8 * c8) = cv[j]; *(LAS v4u*)(Bs + r * LDT + 8 * c8) = bv[j]; }
#pragma unroll
            for (int j = 0; j < 2; ++j) { const int i = tid + NTHR * j, r = i >> 3, c8 = i & 7; float x[8], y[8]; unpack8(xv[j], x);
#pragma unroll
                for (int e = 0; e < 8; ++e) { y[e] = x[e] * xs_sw[j]; x[e] *= xs_sc[j]; }
                *(LAS v4u*)(Xd + r * LDXS + 8 * c8) = pack8(x); *(LAS v4u*)(Xw + r * LDXS + 8 * c8) = pack8(y); }
            if (tid < 128) { CUs[tid] = cu_t; CUs[128 + tid] = dt_t; }
#pragma unroll
            for (int pt = 0; pt < 4; ++pt)
#pragma unroll
                for (int i = 0; i < 4; ++i) Hs[(16 * pt + 4 * fq + i) * LDT + 16 * w + r16] = (bf16)f2bf(hreg[pt][i]);
            __syncthreads();
            if (c + 1 < NCHUNK) SF_LOAD(c + 1);
            const int trow = row0 + 16 * w + r16; const float cum_t = CUs[16 * w + r16];
            v2u xrv[4], zrv[4];
#pragma unroll
            for (int pt = 0; pt < 4; ++pt) { const int ch = 64 * h + 16 * pt + 4 * fq; xrv[pt] = *(const GAS v2u*)(XC + (size_t)trow * XBC + ch); zrv[pt] = *(const GAS v2u*)(ZX + (size_t)trow * AIN_N + ZX_Z + ch); }
            bf16x8 cf[4];
#pragma unroll
            for (int ks = 0; ks < 4; ++ks) cf[ks] = *(const LAS bf16x8*)(Cs + (16 * w + r16) * LDT + 32 * ks + 8 * fq);
            f32x4 cb[8];
#pragma unroll
            for (int st = 0; st < 8; ++st) { cb[st] = (f32x4){0.f, 0.f, 0.f, 0.f};
                if (st <= w) {
#pragma unroll
                    for (int ks = 0; ks < 4; ++ks) { const bf16x8 bf_ = *(const LAS bf16x8*)(Bs + (16 * st + r16) * LDT + 32 * ks + 8 * fq); cb[st] = MFMA16(bf_, cf[ks], cb[st]); } } }
            f32x4 acc[4];
#pragma unroll
            for (int pt = 0; pt < 4; ++pt) { acc[pt] = (f32x4){0.f, 0.f, 0.f, 0.f};
#pragma unroll
                for (int ks = 0; ks < 4; ++ks) { const bf16x8 hf = *(const LAS bf16x8*)(Hs + (16 * pt + r16) * LDT + 32 * ks + 8 * fq); acc[pt] = MFMA16(hf, cf[ks], acc[pt]); }
                acc[pt] = acc[pt] * __expf(cum_t); }
#pragma unroll
            for (int kk = 0; kk < 4; ++kk) {
                if (2 * kk <= w) {
                    f32x4 ga, gb;
#pragma unroll
                    for (int i = 0; i < 4; ++i) { const int sa = 32 * kk + 4 * fq + i, sb = sa + 16;
                        ga[i] = (sa <= 16 * w + r16) ? cb[2 * kk][i] * __expf(cum_t - CUs[sa]) : 0.f;
                        gb[i] = (sb <= 16 * w + r16) ? cb[2 * kk + 1][i] * __expf(cum_t - CUs[sb]) : 0.f; }
                    const bf16x8 pf = pack_p(ga, gb);
#pragma unroll
                    for (int pt = 0; pt < 4; ++pt) { const bf16x8 xf = tr_frag(Xd, LDXS, 32 * kk + 4 * fq, 32 * kk + 16 + 4 * fq, 16 * pt, lane); acc[pt] = MFMA16(xf, pf, acc[pt]); }
                } }
            float ssq = 0.f;
#pragma unroll
            for (int pt = 0; pt < 4; ++pt) { const int ch = 64 * h + 16 * pt + 4 * fq;
                const v2u xr = xrv[pt], zr = zrv[pt];
                f32x4 y = acc[pt] + (f32x4){bflo(xr.x), bfhi(xr.x), bflo(xr.y), bfhi(xr.y)} * dsk;
                y[0] *= siluf(bflo(zr.x)); y[1] *= siluf(bfhi(zr.x)); y[2] *= siluf(bflo(zr.y)); y[3] *= siluf(bfhi(zr.y));
                v2u yp; yp.x = pk2(y[0], y[1]); yp.y = pk2(y[2], y[3]); *(GAS v2u*)(MIX + (size_t)trow * PD + ch) = yp;
                ssq += (y[0] * y[0] + y[1] * y[1]) + (y[2] * y[2] + y[3] * y[3]); }
            ssq += __shfl_xor(ssq, 16); ssq += __shfl_xor(ssq, 32);
            if (fq == 0) SSQH[(size_t)trow * NH + h] = ssq;
            bf16x8 bfr[4];
#pragma unroll
            for (int ks = 0; ks < 4; ++ks) bfr[ks] = tr_frag(Bs, LDT, 32 * ks + 8 * fq, 32 * ks + 8 * fq + 4, 16 * w, lane);
            const float dec = __expf(CUs[127]);
#pragma unroll
            for (int pt = 0; pt < 4; ++pt) { f32x4 sacc = (f32x4){0.f, 0.f, 0.f, 0.f};
#pragma unroll
                for (int ks = 0; ks < 4; ++ks) { const bf16x8 af = tr_frag(Xw, LDXS, 32 * ks + 8 * fq, 32 * ks + 8 * fq + 4, 16 * pt, lane); sacc = MFMA16(af, bfr[ks], sacc); }
                hreg[pt] = hreg[pt] * dec + sacc; }
        }
        float* sp = F.out + O_SSMP + ((size_t)(b * NH + h) * HP + 4 * fq) * NST + 16 * w + r16;
#pragma unroll
        for (int pt = 0; pt < 4; ++pt)
#pragma unroll
            for (int i = 0; i < 4; ++i) sp[(size_t)(16 * pt + i) * NST] = hreg[pt][i];
        __syncthreads();
    }
}
__device__ __forceinline__ void ssd_rescale(Frame& F) {
    const int gt = F.vcu * NTHR + F.tid, NT = F.G * NTHR;
    bf16* MIX = WSP(bf16, WS_MIX); const float* SSQH = WSP(float, WS_SST);
    for (int it0 = gt; it0 < MPR * (SSM_INNER / 8); it0 += 4 * NT) {
        v4u raw[4]; float ssum[4], ggv[4][8];
#pragma unroll
        for (int jj = 0; jj < 4; ++jj) { const int it = it0 + jj * NT; if (it < MPR * (SSM_INNER / 8)) { const int row = it / (SSM_INNER / 8), c8 = it % (SSM_INNER / 8), g = c8 / 48; raw[jj] = *(const GAS v4u*)(MIX + (size_t)row * PD + 8 * c8);
            const float* sq = SSQH + (size_t)row * NH + 6 * g; ssum[jj] = ((sq[0] + sq[1]) + (sq[2] + sq[3])) + (sq[4] + sq[5]); ld8f(INP(I_GSSM) + 8 * c8, ggv[jj]); } }
#pragma unroll
        for (int jj = 0; jj < 4; ++jj) { const int it = it0 + jj * NT; if (it < MPR * (SSM_INNER / 8)) { const int row = it / (SSM_INNER / 8), c8 = it % (SSM_INNER / 8);
            const float rs = 1.0f / sqrtf(ssum[jj] * (1.0f / 384.0f) + EPS);
            float x[8]; unpack8(raw[jj], x); const float (&gg)[8] = ggv[jj];
#pragma unroll
            for (int e = 0; e < 8; ++e) x[e] *= rs * gg[e];
            *(GAS v4u*)(MIX + (size_t)row * PD + 8 * c8) = pack8(x); } }
    }
}
__device__ __forceinline__ void ssd_sample(Frame& F) {
    LAS float* us = (LAS float*)(F.lds + 0);
    const bf16* XC = WSP(bf16, WS_XC); const bf16* ZX = WSP(bf16, WS_ZX); const float* DTV = WSP(float, WS_DTV); const float* CUM = WSP(float, WS_CUM); bf16* MIX = WSP(bf16, WS_MIX);
    const int lane = F.lane, w = F.wave;
    for (int u = (F.G >= 256) ? F.vcu - 224 : F.vcu; u >= 0 && u < NSMP * NG; u += (F.G >= 256) ? 32 : F.G) {
        const int b = u >> 3, g = u & 7, row = MPR + b;
        __syncthreads();
        const unsigned br = *(const GAS unsigned*)(XC + (size_t)row * XBC + SSM_INNER + 128 * g + 2 * lane), cr = *(const GAS unsigned*)(XC + (size_t)row * XBC + SSM_INNER + 1024 + 128 * g + 2 * lane);
        const float B0 = bflo(br), B1 = bfhi(br), C0 = bflo(cr), C1 = bfhi(cr);
        for (int i0 = w; i0 < 384; i0 += 4 * NWAVES) {
            f32x2 hp[4]; float dtv[4], dav[4], xsv[4], zv[4];
#pragma unroll
            for (int j = 0; j < 4; ++j) { const int i = i0 + 8 * j, hh = i >> 6, p = i & 63, h = 6 * g + hh, ch = 64 * h + p;
                hp[j] = *(const f32x2*)(INP(I_SSM) + ((size_t)(b * NH + h) * HP + p) * NST + 2 * lane);
                dtv[j] = DTV[(size_t)row * NH + vgpr_i(h)]; dav[j] = CUM[(size_t)row * NH + vgpr_i(h)]; xsv[j] = bf2f(XC[(size_t)row * XBC + vgpr_i(ch)]); zv[j] = bf2f(ZX[(size_t)row * AIN_N + ZX_Z + vgpr_i(ch)]); }
#pragma unroll
            for (int j = 0; j < 4; ++j) { const int i = i0 + 8 * j, hh = i >> 6, p = i & 63, h = 6 * g + hh;
                const float dA = __expf(dav[j]), xdt = xsv[j] * dtv[j];
                const f32x2 hn = (f32x2){hp[j].x * dA + xdt * B0, hp[j].y * dA + xdt * B1};
                *(GAS f32x2*)(F.out + O_SSMS + ((size_t)(b * NH + h) * HP + p) * NST + 2 * lane) = hn;
                float y = wave_sum(hn.x * C0 + hn.y * C1) + INP(I_DSKIP)[h] * xsv[j];
                y *= siluf(zv[j]);
                if (lane == 0) us[i] = y; }
        }
        __syncthreads();
        float part = 0.f; for (int i = F.tid; i < 384; i += NTHR) part += us[i] * us[i];
        part = wave_sum(part); if (lane == 0) us[384 + w] = part;
        __syncthreads();
        float tot = 0.f;
#pragma unroll
        for (int k = 0; k < NWAVES; ++k) tot += us[384 + k];
        const float rs = 1.0f / sqrtf(tot * (1.0f / 384.0f) + EPS);
        for (int i = F.tid; i < 384; i += NTHR) { const int ch = 384 * g + i; MIX[(size_t)row * PD + ch] = (bf16)f2bf(us[i] * rs * INP(I_GSSM)[ch]); }
    }
    __syncthreads();
}

__device__ __forceinline__ void e_ffn(Frame& F, int l) {
    const int gt = F.vcu * NTHR + F.tid, NT = F.G * NTHR;
    const bf16* GU = WSP(bf16, WS_GU); bf16* H = WSP(bf16, WS_H);
    const float* wcv = INP(I_WFCONV) + (size_t)l * 3 * DFF; const float* bcv = INP(I_BFCONV) + (size_t)l * DFF;
    const float* TAIL = WSP(float, WS_TAIL); const float* HG = WSP(float, WS_HEADG); const float* HU = WSP(float, WS_HEADU);
    for (int it = gt; it < 64 * (DFF / 8); it += NT) {
        const int pj = it / (DFF / 8), ch = (it % (DFF / 8)) * 8, pm = pj >> 1, j = pj & 1, row = 256 * pm + j;
        float w0[8], w1[8], w2[8], bb[8], p1[8], p2[8], x[8], up[8], y[8];
        ld8f(wcv + ch, w0); ld8f(wcv + DFF + ch, w1); ld8f(wcv + 2 * DFF + ch, w2); ld8f(bcv + ch, bb);
        ld8f(HG + (size_t)pj * DFF + ch, x); ld8f(HU + (size_t)pj * DFF + ch, up);
        const bool seq0 = (pm & 7) == 0;
        if (j == 0) { if (seq0) {
#pragma unroll
                for (int e = 0; e < 8; ++e) { p1[e] = 0.f; p2[e] = 0.f; } }
            else { ld8f(TAIL + ((size_t)(pm - 1) * 2 + 1) * DFF + ch, p1); ld8f(TAIL + ((size_t)(pm - 1) * 2) * DFF + ch, p2); } }
        else { ld8f(HG + (size_t)(pj - 1) * DFF + ch, p1);
            if (seq0) {
#pragma unroll
                for (int e = 0; e < 8; ++e) p2[e] = 0.f; }
            else ld8f(TAIL + ((size_t)(pm - 1) * 2 + 1) * DFF + ch, p2); }
#pragma unroll
        for (int e = 0; e < 8; ++e) y[e] = siluf(bb[e] + w0[e] * p2[e] + w1[e] * p1[e] + w2[e] * x[e]) * up[e];
        *(GAS v4u*)(H + (size_t)row * PF + ch) = pack8(y);
    }
    for (int it = gt; it < NSMP * (DFF / 8); it += NT) {
        const int b = it / (DFF / 8), ch = (it % (DFF / 8)) * 8, row = MPR + b, gc = 256 * (ch >> 7) + (ch & 127), uc = gc + 128;
        float w0[8], w1[8], w2[8], bb[8], p0[8], p1[8], x[8], up[8], y[8];
        ld8f(wcv + ch, w0); ld8f(wcv + DFF + ch, w1); ld8f(wcv + 2 * DFF + ch, w2); ld8f(bcv + ch, bb);
        const float* st = INP(I_FFNCONV) + (size_t)(l * NSMP + b) * 2 * DFF + ch; ld8f(st, p0); ld8f(st + DFF, p1);
        unpack8(*(const GAS v4u*)(GU + (size_t)row * UP_N + gc), x); unpack8(*(const GAS v4u*)(GU + (size_t)row * UP_N + uc), up);
#pragma unroll
        for (int j = 0; j < 8; ++j) y[j] = siluf(bb[j] + w0[j] * p0[j] + w1[j] * p1[j] + w2[j] * x[j]) * up[j];
        *(GAS v4u*)(H + (size_t)row * PF + ch) = pack8(y);
        float* fs = F.out + O_FFNS + (size_t)(l * NSMP + b) * 2 * DFF + ch; st8f(fs, p1); st8f(fs + DFF, x);
    }
}

__device__ __forceinline__ int dil_r(int g) { return g == 0 ? 1 : (g == 1 ? 4 : 16); }
__device__ __forceinline__ size_t wk_off_p(int g) { return g == 0 ? O_WK0P : (g == 1 ? O_WK1P : O_WK2P); }
__device__ __forceinline__ size_t wk_off_s(int g) { return g == 0 ? O_WK0S : (g == 1 ? O_WK1S : O_WK2S); }
__device__ __forceinline__ void dil_attn_prompt(Frame& F) {
    LAS unsigned char* TK = F.lds; LAS unsigned char* TV = F.lds + 65536;
    const int tid = F.tid, lane = F.lane, w = F.wave, r16 = lane & 15, fq = lane >> 4;
    const bf16* KS = WSP(bf16, WS_KS); const bf16* QS = WSP(bf16, WS_QS); const bf16* VT = WSP(bf16, WS_VT); bf16* OG = WSP(bf16, WS_OG); float* LSE = WSP(float, WS_LSE);
    v4u sk[8], sv[8];
#define DIL_DECODE(u_) const int g = (u_) >> 9, q = (u_) & 511, r = dil_r(g), L = SEQ / r, nblk = L >> 7, jb = q % nblk, sq = q / nblk, j0 = 128 * jb; const size_t sbase = (size_t)g * 65536 + (size_t)sq * L;
#define DIL_PREFETCH(u_) do { DIL_DECODE(u_) \
        _Pragma("unroll") for (int j = 0; j < 8; ++j) { const int i = tid + 512 * j; int kj = j0 - 128 + (i >> 4); kj += (kj < 0) ? 128 : 0; sk[j] = *(const GAS v4u*)(KS + (sbase + kj) * 128 + 8 * (i & 15)); } \
        _Pragma("unroll") for (int j = 0; j < 8; ++j) { const int i = tid + 512 * j; int vj = j0 - 128 + (i >> 4); vj += (vj < 0) ? 128 : 0; sv[j] = *(const GAS v4u*)(VT + (sbase + vj) * 128 + 8 * (i & 15)); } } while (0)
    int u = F.vcu;
    if (u < 1536) DIL_PREFETCH(u);
    for (; u < 1536; u += F.G) {
        DIL_DECODE(u)
        const int rho = sq % r, bh = sq / r, b = bh >> 3, h = bh & 7;
        __syncthreads();
#pragma unroll
        for (int j = 0; j < 8; ++j) { const int rr = tid >> 4, c = tid & 15; *(LAS v4u*)(TK + rr * 256 + 16 * (c ^ (rr & 15)) + j * 8192) = sk[j]; }
#pragma unroll
        for (int j = 0; j < 8; ++j) { const int rr = tid >> 4, c = tid & 15; *(LAS v4u*)(TV + rr * 288 + 16 * c + j * 9216) = sv[j]; }
        __syncthreads();
        if (u + F.G < 1536) DIL_PREFETCH(u + F.G);
        const int jq0 = j0 + 16 * w;
        bf16x8 qf[4];
#pragma unroll
        for (int ks = 0; ks < 4; ++ks) qf[ks] = *(const GAS bf16x8*)(QS + (sbase + jq0 + r16) * 128 + 32 * ks + 8 * fq);
        f32x4 acc[9];
#pragma unroll
        for (int kt = 0; kt < 9; ++kt) {
            const int R = 16 * w + 16 * kt;
            if (jq0 - 128 + 16 * kt >= 0) { f32x4 a = (f32x4){0.f, 0.f, 0.f, 0.f}; const int rr = R + r16;
#pragma unroll
                for (int ks = 0; ks < 4; ++ks) { const int c = 4 * ks + fq; const bf16x8 kf = *(const LAS bf16x8*)(TK + rr * 256 + 16 * (c ^ (rr & 15))); a = MFMA16(kf, qf[ks], a); }
                acc[kt] = a; }
            else acc[kt] = (f32x4){-INFINITY, -INFINITY, -INFINITY, -INFINITY};
            __builtin_amdgcn_sched_barrier(0);
        }
#pragma unroll
        for (int i = 0; i < 4; ++i) { const int kk = 4 * fq + i; if (kk < r16) acc[0][i] = -INFINITY; if (kk > r16) acc[8][i] = -INFINITY; }
        float mx = -INFINITY;
#pragma unroll
        for (int kt = 0; kt < 9; ++kt) mx = fmaxf(fmaxf(fmaxf(acc[kt][0], acc[kt][1]), fmaxf(acc[kt][2], acc[kt][3])), mx);
        mx = fmaxf(mx, __shfl_xor(mx, 16)); mx = fmaxf(mx, __shfl_xor(mx, 32));
        float sum = 0.f;
#pragma unroll
        for (int kt = 0; kt < 9; ++kt) {
#pragma unroll
            for (int i = 0; i < 4; ++i) { acc[kt][i] = __expf(acc[kt][i] - mx); sum += acc[kt][i]; } }
        sum += __shfl_xor(sum, 16); sum += __shfl_xor(sum, 32);
        const float inv = 1.0f / sum;
        f32x4 o[8];
#pragma unroll
        for (int dt = 0; dt < 8; ++dt) o[dt] = (f32x4){0.f, 0.f, 0.f, 0.f};
#pragma unroll
        for (int k2 = 0; k2 < 5; ++k2) {
            if (k2 == 4 || jq0 - 128 + 32 * k2 + 16 >= 0) {
                const bf16x8 pf = (k2 == 4) ? pack_p(acc[8], (f32x4){0.f, 0.f, 0.f, 0.f}) : pack_p(acc[2 * k2 < 9 ? 2 * k2 : 8], acc[2 * k2 + 1 < 9 ? 2 * k2 + 1 : 8]);
                const int kA = 16 * w + 32 * k2 + 4 * fq, kB = (k2 == 4) ? kA : kA + 16;
#pragma unroll
                for (int dt = 0; dt < 8; ++dt) { const bf16x8 vf = tr_frag((const LAS bf16*)TV, 144, kA, kB, 16 * dt, lane); o[dt] = MFMA16(vf, pf, o[dt]); }
            }
            __builtin_amdgcn_sched_barrier(0);
        }
        const int trow = b * SEQ + rho + r * (jq0 + r16);
        bf16* op = OG + ((size_t)g * MPR + trow) * 1024 + 128 * h + 4 * fq;
#pragma unroll
        for (int dt = 0; dt < 8; ++dt) { v2u wv; wv.x = pk2(o[dt][0] * inv, o[dt][1] * inv); wv.y = pk2(o[dt][2] * inv, o[dt][3] * inv); *(GAS v2u*)(op + 16 * dt) = wv; }
        if (fq == 0) LSE[((size_t)g * MPR + trow) * 8 + h] = mx + __logf(sum);
    }
#undef DIL_DECODE
#undef DIL_PREFETCH
    __syncthreads();
}
__device__ __forceinline__ void win_out_pass(Frame& F, int widx, int nw) {
    const int gt = widx * NTHR + F.tid, NT = nw * NTHR;
    const bf16* KS = WSP(bf16, WS_KS); const bf16* VS = WSP(bf16, WS_VT);
    constexpr int NP0 = BATCH * 128 * 256, NP1 = BATCH * 512 * 256, NP2 = BATCH * 2048 * 256;
    for (int it0 = gt; it0 < NP0 + NP1 + NP2; it0 += 8 * NT) {
        v4u raw[8];
#pragma unroll
        for (int jj = 0; jj < 8; ++jj) { const int it = it0 + jj * NT; if (it < NP0 + NP1 + NP2) {
            const int g = it < NP0 ? 0 : (it < NP0 + NP1 ? 1 : 2), q = it - (g == 0 ? 0 : (g == 1 ? NP0 : NP0 + NP1)), lr = 2 * g, L = SEQ >> lr, Lw = 128 << lr;
            const int c = q & 15, h = (q >> 4) & 7, kv = (q >> 7) & 1, tw = (q >> 8) % Lw, b = (q >> 8) / Lw, t = SEQ - Lw + tw;
            const size_t sg = ((size_t)((b * 8 + h) << lr) + (t & ((1 << lr) - 1))) * L + (t >> lr);
            raw[jj] = *(const GAS v4u*)((kv ? VS : KS) + ((size_t)g * 65536 + sg) * 128 + 8 * c); } }
#pragma unroll
        for (int jj = 0; jj < 8; ++jj) { const int it = it0 + jj * NT; if (it < NP0 + NP1 + NP2) {
            const int g = it < NP0 ? 0 : (it < NP0 + NP1 ? 1 : 2), q = it - (g == 0 ? 0 : (g == 1 ? NP0 : NP0 + NP1));
            float y[8]; unpack8(raw[jj], y);
            st8f(F.out + (g == 0 ? O_WK0P : (g == 1 ? O_WK1P : O_WK2P)) + (size_t)q * 8, y); } }
    }
}
__device__ __forceinline__ void dil_merge(Frame& F) {
    const int gt = F.vcu * NTHR + F.tid, NT = F.G * NTHR;
    const bf16* OG = WSP(bf16, WS_OG); const float* LSE = WSP(float, WS_LSE); bf16* MIX2 = WSP(bf16, WS_MIX2);
    for (int it0 = gt; it0 < MPR * 128; it0 += 4 * NT) {
        float l0[4], l1[4], l2[4]; v4u ra[4], rb[4], rc[4];
#pragma unroll
        for (int jj = 0; jj < 4; ++jj) { const int it = it0 + jj * NT; if (it < MPR * 128) { const int row = it >> 7, c8 = it & 127, h = c8 >> 4;
            l0[jj] = LSE[(size_t)row * 8 + h]; l1[jj] = LSE[((size_t)MPR + row) * 8 + h]; l2[jj] = LSE[((size_t)2 * MPR + row) * 8 + h];
            ra[jj] = *(const GAS v4u*)(OG + (size_t)row * 1024 + 8 * c8); rb[jj] = *(const GAS v4u*)(OG + ((size_t)MPR + row) * 1024 + 8 * c8); rc[jj] = *(const GAS v4u*)(OG + ((size_t)2 * MPR + row) * 1024 + 8 * c8); } }
#pragma unroll
        for (int jj = 0; jj < 4; ++jj) { const int it = it0 + jj * NT; if (it < MPR * 128) { const int row = it >> 7, c8 = it & 127;
            const float m = fmaxf(l0[jj], fmaxf(l1[jj], l2[jj]));
            float w0 = __expf(l0[jj] - m), w1 = __expf(l1[jj] - m), w2 = __expf(l2[jj] - m); const float inv = 1.0f / (w0 + w1 + w2); w0 *= inv; w1 *= inv; w2 *= inv;
            float a[8], bq[8], c[8], o[8];
            unpack8(ra[jj], a); unpack8(rb[jj], bq); unpack8(rc[jj], c);
#pragma unroll
            for (int j = 0; j < 8; ++j) o[j] = w0 * a[j] + w1 * bq[j] + w2 * c[j];
            *(GAS v4u*)(MIX2 + (size_t)row * P2 + 8 * c8) = pack8(o); } }
    }
}
__device__ __forceinline__ void dil_attn_sample(Frame& F) {
    LAS float* qs = (LAS float*)(F.lds + 0); LAS float* ksn = qs + 384; LAS float* vsn = qs + 768; LAS float* ps = qs + 1152; LAS float* red = qs + 1664; LAS float* part = qs + 1680;
    const int tid = F.tid, lane = F.lane, w = F.wave;
    const bf16* KVQ = WSP(bf16, WS_KVQ); const float* ROPE = WSP(float, WS_ROPE);
    for (int u = F.vcu; u < NSMP * 8; u += F.G) {
        const int b = u >> 3, h = u & 7, row = MPR + b;
        __syncthreads();
        for (int vv = w; vv < 9; vv += NWAVES) {
            const int kind = vv / 3, g = vv % 3, d = 2 * lane;
            const int col = (kind == 0) ? KQ_Q + g * 1024 + h * 128 : (kind == 1 ? g * 2048 + h * 128 : g * 2048 + 1024 + h * 128);
            const unsigned raw = *(const GAS unsigned*)(KVQ + (size_t)row * KVQ_N + col + d);
            float y0 = bflo(raw), y1 = bfhi(raw);
            if (kind != 2) {
                const float rs = 1.0f / sqrtf(wave_sum(y0 * y0 + y1 * y1) * (1.0f / 128.0f) + EPS);
                const float* gn = (kind == 1 ? INP(I_GKDIL) : INP(I_GQDIL)) + g * 128 + d;
                y0 *= rs * gn[0]; y1 *= rs * gn[1];
                const float o0 = __shfl_xor(y0, 8), o1 = __shfl_xor(y1, 8);
                if (lane < 16) { const int i0 = (lane & 7) * 2; const float c0 = ROPE[2048 * 32 + i0], c1 = ROPE[2048 * 32 + i0 + 1], s0 = ROPE[2048 * 32 + 16 + i0], s1 = ROPE[2048 * 32 + 16 + i0 + 1];
                    if (lane < 8) { y0 = y0 * c0 - o0 * s0; y1 = y1 * c1 - o1 * s1; } else { y0 = y0 * c0 + o0 * s0; y1 = y1 * c1 + o1 * s1; } }
                if (kind == 0) { y0 *= 0.08838834764831845f; y1 *= 0.08838834764831845f; }
            }
            LAS float* dst = (kind == 0 ? qs : (kind == 1 ? ksn : vsn)) + g * 128 + d; dst[0] = y0; dst[1] = y1;
            if (kind != 0) *(GAS f32x2*)(F.out + wk_off_s(g) + (size_t)(b * 2 + (kind == 2 ? 1 : 0)) * 1024 + h * 128 + d) = (f32x2){y0, y1};
        }
        __syncthreads();
        float sc = -INFINITY;
        if (tid < 387) { const int g = tid / 129, k = tid % 129, r = dil_r(g), W = (g == 0 ? 128 : (g == 1 ? 512 : 2048)); float a = 0.f;
            if (k == 0) {
#pragma unroll 8
                for (int d4 = 0; d4 < 32; ++d4) { const f32x4 kv = *(const LAS f32x4*)(ksn + g * 128 + 4 * d4); const f32x4 qv = *(const LAS f32x4*)(qs + g * 128 + 4 * d4); a += (kv.x * qv.x + kv.y * qv.y) + (kv.z * qv.z + kv.w * qv.w); } }
            else { const float* krow = INP(I_WIN0 + (g == 0 ? 0 : (g == 1 ? 1 : 2))) + ((size_t)b * W + (W - k * r)) * 2048 + h * 128;
#pragma unroll 8
                for (int d4 = 0; d4 < 32; ++d4) { const f32x4 kv = *(const GAS f32x4*)(krow + 4 * d4); const f32x4 qv = *(const LAS f32x4*)(qs + g * 128 + 4 * d4); a += (kv.x * qv.x + kv.y * qv.y) + (kv.z * qv.z + kv.w * qv.w); } }
            sc = a; }
        const float wm = wave_max(sc); if (lane == 0) red[w] = wm;
        __syncthreads();
        float mx = red[0];
#pragma unroll
        for (int k = 1; k < 8; ++k) mx = fmaxf(mx, red[k]);
        const float pr = (tid < 387) ? __expf(sc - mx) : 0.f; ps[tid] = pr;
        const float wsum = wave_sum(pr); if (lane == 0) red[8 + w] = wsum;
        __syncthreads();
        float den = 0.f;
#pragma unroll
        for (int k = 0; k < 8; ++k) den += red[8 + k];
        { const int d = tid & 127, qt = tid >> 7; float o = 0.f;
#pragma unroll 1
          for (int g = 0; g < 3; ++g) { const int r = dil_r(g), W = (g == 0 ? 128 : (g == 1 ? 512 : 2048));
              const float* vb = INP(I_WIN0 + (g == 0 ? 0 : (g == 1 ? 1 : 2))) + ((size_t)b * W + W) * 2048 + 1024 + h * 128 + d;
              if (qt == 0) o += vsn[g * 128 + d] * ps[g * 129];
#pragma unroll 1
              for (int jb = 0; jb < 2; ++jb) { float vv[16];
#pragma unroll
                  for (int j = 0; j < 16; ++j) { const int k = 1 + qt + 4 * (16 * jb + j); vv[j] = *(const GAS float*)(vb - (size_t)k * r * 2048); }
#pragma unroll
                  for (int j = 0; j < 16; ++j) { const int k = 1 + qt + 4 * (16 * jb + j); o += vv[j] * ps[g * 129 + k]; } } }
          part[tid] = o; }
        __syncthreads();
        if (tid < 128) WSP(bf16, WS_MIX2)[(size_t)(MPR + b) * P2 + 128 * h + tid] = (bf16)f2bf(((part[tid] + part[128 + tid]) + (part[256 + tid] + part[384 + tid])) / den);
    }
    __syncthreads();
}

constexpr int SSQS_SLOTS = 256;
template <bool RESID, bool FINAL = false>
__device__ __forceinline__ void skinny_gemm(Frame& F, const bf16* A, int lda, const bf16* Bt, int ldb, int N, int K, bf16* Ob, int ldo, const float* res, float* outf, float* ssqs) {
    LAS float* red = (LAS float*)(F.lds + 0);
    const int lane = F.lane, w = F.wave, r16 = lane & 15, fq = lane >> 4, kw = K / 8, k0 = w * kw;
    LAS float* rsv = (LAS float*)(F.lds + 8192);
    if constexpr (!RESID) { const f32x4 q4 = *(const GAS f32x4*)(ssqs + w * SSQS_SLOTS + 4 * lane); const float sq = wave_sum((q4.x + q4.y) + (q4.z + q4.w)); if (lane == 0) rsv[w] = 1.0f / sqrtf(sq * (1.0f / 4096.0f) + EPS); }
    bf16x8 af[16], bc[16], bn[16];
    if constexpr (!RESID) { const bf16* ap = A + (size_t)(r16 & 7) * lda + k0 + 8 * fq;
#pragma unroll
        for (int j = 0; j < 16; ++j) { af[j] = *(const GAS bf16x8*)(ap + 32 * j); if (r16 >= 8) af[j] = (bf16x8){0, 0, 0, 0, 0, 0, 0, 0}; }
        if (F.vcu < N / 16) { const bf16* bp = Bt + (size_t)(16 * F.vcu + r16) * ldb + k0 + 8 * fq;
#pragma unroll
            for (int j = 0; j < 16; ++j) bc[j] = *(const GAS bf16x8*)(bp + 32 * j); } }
    for (int tile = F.vcu; tile < N / 16; tile += F.G) {
        f32x4 acc = (f32x4){0.f, 0.f, 0.f, 0.f};
        if constexpr (!RESID) {
            if (tile + F.G < N / 16) { const bf16* bp = Bt + (size_t)(16 * (tile + F.G) + r16) * ldb + k0 + 8 * fq;
#pragma unroll
                for (int j = 0; j < 16; ++j) bn[j] = *(const GAS bf16x8*)(bp + 32 * j); }
#pragma unroll
            for (int j = 0; j < 16; ++j) acc = MFMA16(af[j], bc[j], acc);
#pragma unroll
            for (int j = 0; j < 16; ++j) bc[j] = bn[j];
        } else {
        const bf16* bp = Bt + (size_t)(16 * tile + r16) * ldb + k0 + 8 * fq; const bf16* ap = A + (size_t)(r16 & 7) * lda + k0 + 8 * fq;
#pragma unroll 16
        for (int k = 0; k < kw; k += 32) { const bf16x8 bfr = *(const GAS bf16x8*)(bp + k); bf16x8 afr = *(const GAS bf16x8*)(ap + k); if (r16 >= 8) afr = (bf16x8){0, 0, 0, 0, 0, 0, 0, 0}; acc = MFMA16(afr, bfr, acc); }
        }
        __syncthreads();
        *(LAS f32x4*)(red + (w * 64 + lane) * 4) = acc;
        __syncthreads();
        if (w == 0 && fq < 2) {
            f32x4 t = acc;
#pragma unroll
            for (int ww = 1; ww < 8; ++ww) t += *(const LAS f32x4*)(red + (ww * 64 + lane) * 4);
            const int n = 16 * tile + r16;
#pragma unroll
            for (int i = 0; i < 4; ++i) { const int row = 4 * fq + i;
                if constexpr (RESID) { const float v = t[i] + bf2f(Ob[(size_t)row * ldo + n]);
                    if constexpr (FINAL) outf[(size_t)row * D + n] = v;
                    else { Ob[(size_t)row * ldo + n] = (bf16)f2bf(v);
                        float ss = v * v; ss += __shfl_xor(ss, 1); ss += __shfl_xor(ss, 2); ss += __shfl_xor(ss, 4); ss += __shfl_xor(ss, 8); if (r16 == 0) ssqs[row * SSQS_SLOTS + tile] = ss; } }
                else { const float rs = rsv[row]; Ob[(size_t)row * ldo + n] = (bf16)f2bf(t[i] * rs); } }
        }
    }
    __syncthreads();
}

namespace pg8 {
struct EpiKVQ {
    static constexpr bool PERM = true, AFTER_DRAIN = false;
    unsigned char* ws; float* outb; const float* gk; const float* gq; PG8_LAS float* red;
    __device__ __forceinline__ void operator()(const f32x4 (&acc)[2][2][4][2], const Unit& u, int wr, int wc, int fr, int fq) const {
        const int pn = u.pn;
        bf16_t* KVQo = (bf16_t*)(ws + WS_KVQ); bf16_t* KS = (bf16_t*)(ws + WS_KS); bf16_t* VS = (bf16_t*)(ws + WS_VT); bf16_t* QS = (bf16_t*)(ws + WS_QS); const float* ssq = (const float*)(ws + WS_SSQ); const float* rope = (const float*)(ws + WS_ROPE);
        row_scales_lds(ssq, u.pm, wr * 4 + wc, fq * 16 + fr, red + 2048); PG8_LDS_BARRIER();
#define KVQ_RS(ai_, m_) (red[2048 + (ai_) * HALF + wr * 64 + (m_) * 16 + fr])
        if (pn >= 36) {
            const int col0 = pn * BM + wc * 32 + 8 * fq;
#pragma unroll
            for (int ai = 0; ai < 2; ++ai) { float rs4[4];
#pragma unroll
                for (int m = 0; m < 4; ++m) rs4[m] = KVQ_RS(ai, m);
                __builtin_amdgcn_sched_barrier(0);
#pragma unroll
                for (int m = 0; m < 4; ++m) { const int row = u.pm * BM + ai * HALF + wr * 64 + m * 16 + fr; const float rs = rs4[m];
#pragma unroll
                    for (int bj = 0; bj < 2; ++bj) { const f32x4 v0 = acc[ai][bj][m][0] * rs, v1 = acc[ai][bj][m][1] * rs; u32x4 w; w.x = cvt_pk_bf16(v0[0], v0[1]); w.y = cvt_pk_bf16(v0[2], v0[3]); w.z = cvt_pk_bf16(v1[0], v1[1]); w.w = cvt_pk_bf16(v1[2], v1[3]);
                        *(u32x4*)(KVQo + (size_t)row * (10240) + col0 + bj * HALF) = w; } __builtin_amdgcn_sched_barrier(0); } }
            return;
        }
        int g, kind, h0;
        if (pn < 24) { g = pn >> 3; kind = ((pn & 7) >> 2) ? 2 : 0; h0 = 2 * (pn & 3); } else { const int tq = pn - 24; g = tq >> 2; kind = 1; h0 = 2 * (tq & 3); }
        const int lr = (g == 0) ? 0 : (g == 1 ? 2 : 4), L = 2048 >> lr;
        if (kind != 2) {
#pragma unroll
            for (int ai = 0; ai < 2; ++ai)
#pragma unroll
                for (int m = 0; m < 4; ++m) { const float rq = KVQ_RS(ai, m);
#pragma unroll
                    for (int bj = 0; bj < 2; ++bj) { const f32x4 a = acc[ai][bj][m][0], b = acc[ai][bj][m][1];
                        float ss = ((a[0] * a[0] + a[1] * a[1]) + (a[2] * a[2] + a[3] * a[3])) + ((b[0] * b[0] + b[1] * b[1]) + (b[2] * b[2] + b[3] * b[3]));
                        ss += __shfl_xor(ss, 16); ss += __shfl_xor(ss, 32);
                        if (fq == 0) red[((ai * HALF + wr * 64 + m * 16 + fr) * 2 + bj) * 4 + wc] = ss * rq * rq; } __builtin_amdgcn_sched_barrier(0); }
            asm volatile("s_waitcnt lgkmcnt(0)" ::: "memory"); __builtin_amdgcn_s_barrier(); asm volatile("" ::: "memory");
        }
        const float* gn = (kind == 0 ? gk : gq) + g * 128 + wc * 32 + 8 * fq;
        f32x4 g0 = (f32x4){1.f, 1.f, 1.f, 1.f}, g1 = g0; if (kind != 2) { g0 = *(const f32x4*)(gn); g1 = *(const f32x4*)(gn + 4); }
        bf16_t* dst = (kind == 0 ? KS : (kind == 1 ? QS : VS)) + (size_t)g * 65536 * 128 + wc * 32 + 8 * fq;
#pragma unroll
        for (int ai = 0; ai < 2; ++ai) {
            float rs4[4];
#pragma unroll
            for (int m = 0; m < 4; ++m) rs4[m] = KVQ_RS(ai, m);
            __builtin_amdgcn_sched_barrier(0);
            u32x4 wq[4][2];
#pragma unroll
            for (int m = 0; m < 4; ++m) {
                const int rt = ai * HALF + wr * 64 + m * 16 + fr, row = u.pm * BM + rt, t = row & 2047; const float rrow = rs4[m];
#pragma unroll
                for (int bj = 0; bj < 2; ++bj) {
                    float sc = rrow;
                    f32x4 v0 = acc[ai][bj][m][0], v1 = acc[ai][bj][m][1];
                    if (kind != 2) { const f32x4 p4 = *(const PG8_LAS f32x4*)(red + (rt * 2 + bj) * 4); sc *= 1.0f / sqrtf(((p4[0] + p4[1]) + (p4[2] + p4[3])) * (1.0f / 128.0f) + NORM_EPS);
                        v0 = v0 * sc * g0; v1 = v1 * sc * g1;
                        if (wc == 0) { f32x4 o0, o1;
#pragma unroll
                            for (int i = 0; i < 4; ++i) { o0[i] = __shfl_xor(v0[i], 32); o1[i] = __shfl_xor(v1[i], 32); }
                            const float* rp = rope + t * 32 + 8 * (fq & 1); const f32x4 c0 = *(const f32x4*)(rp), c1 = *(const f32x4*)(rp + 4), s0 = *(const f32x4*)(rp + 16), s1 = *(const f32x4*)(rp + 20);
                            if (fq < 2) { v0 = v0 * c0 - o0 * s0; v1 = v1 * c1 - o1 * s1; } else { v0 = v0 * c0 + o0 * s0; v1 = v1 * c1 + o1 * s1; } }
                        if (kind == 1) { v0 = v0 * 0.08838834764831845f; v1 = v1 * 0.08838834764831845f; } }
                    else { v0 = v0 * sc; v1 = v1 * sc; }
                    u32x4 w; w.x = cvt_pk_bf16(v0[0], v0[1]); w.y = cvt_pk_bf16(v0[2], v0[3]); w.z = cvt_pk_bf16(v1[0], v1[1]); w.w = cvt_pk_bf16(v1[2], v1[3]);
                    wq[m][bj] = w;
                }
                __builtin_amdgcn_sched_barrier(0);
            }
#pragma unroll
            for (int m = 0; m < 4; ++m) {
                const int row = u.pm * BM + ai * HALF + wr * 64 + m * 16 + fr, b = row >> 11, t = row & 2047;
#pragma unroll
                for (int bj = 0; bj < 2; ++bj) { const int h = h0 + bj;
                    const size_t sg = ((size_t)((b * 8 + h) << lr) + (t & ((1 << lr) - 1))) * L + (t >> lr);
                    *(u32x4*)(dst + sg * 128) = wq[m][bj]; }
            }
            __builtin_amdgcn_sched_barrier(0);
        }
#undef KVQ_RS
    }
};

}

constexpr int N_PHASES = 18;
__global__ void __launch_bounds__(NTHR, 2) yoco_fwd(Args args) {
    extern __shared__ __attribute__((aligned(16))) unsigned char lds[];
    Frame F;
    F.lds = (LAS unsigned char*)lds;
    F.wave = __builtin_amdgcn_readfirstlane((int)threadIdx.x >> 6); F.lane = lane_id(); F.tid = F.wave * 64 + F.lane;
    F.G = gridDim.x; { const int bx = blockIdx.x; F.vcu = (F.G % 8 == 0) ? (bx % 8) * (F.G / 8) + bx / 8 : bx; }
    F.in = args.in; F.out = args.out; F.ws = args.ws;
    volatile LAS unsigned* MISC = (volatile LAS unsigned*)(F.lds + MISC_OFF);
    if (F.tid < 64) MISC[F.tid] = 0u;
    __syncthreads();
    XcdBarrier bar; bar.bar = (unsigned*)(F.ws + WS_CTL) + CW_BAR; bar.x = 0; bar.st = nullptr;
#if !MK_SPLIT
    bar = xcd_barrier_post((unsigned*)(F.ws + WS_CTL) + CW_BAR, MISC + 8, F.tid == 0);
#define GRID_BAR() xcd_barrier(bar, F.wave == 0 && lane_id() == 0)
#else
#define GRID_BAR() do {} while (0)
#endif
    const int lo = args.ph_lo, hi = args.ph_hi;
#define IN(k) (lo <= (k) && (k) < hi)
#define REFRESH() do { int l_ = lane_id(); asm volatile("" : "+v"(l_)); F.lane = l_; F.tid = F.wave * 64 + l_; } while (0)
#define BOTH(k) (IN(k) && IN((k) + 1))
#define GEMM_SCALE(Aoff, Boff, Mrows, Ncols, Ooff, SSQoff, rot) do { pg8::Gemm g{WSP(bf16, Aoff), WSP(bf16, Boff), Mrows, Ncols, D, PD, PD}; pg8::StaticOrder S; S.init(Mrows, Ncols, F.G, (int)((blockIdx.x + F.G - (rot) % F.G) % F.G)); \
        pg8::EpiScale E{WSP(bf16, Ooff), Ncols, WSP(float, SSQoff), (LAS float*)(F.lds + RING_BYTES) + 2048}; pg8::gemm_phase<pg8::EpiScale, pg8::StaticOrder, true, true>(F.lds + RING_OFF, g, S, E, F.wave); } while (0)
#define GEMM_FFN(Boff, l) do { pg8::Gemm g{WSP(bf16, WS_XB), WSP(bf16, Boff), MPR, UP_N, D, PD, PD}; pg8::StaticOrder S; S.init(MPR, UP_N, F.G, (int)blockIdx.x); \
        pg8::EpiFFN E{WSP(bf16, WS_H), PF, WSP(float, WS_SSQ), INP(I_WFCONV) + (size_t)(l) * 3 * DFF, INP(I_BFCONV) + (size_t)(l) * DFF, WSP(float, WS_TAIL), WSP(float, WS_HEADG), WSP(float, WS_HEADU), F.out + O_FFNP + (size_t)(l) * BATCH * 2 * DFF, (LAS float*)(F.lds + RING_BYTES), DFF}; \
        pg8::gemm_phase<pg8::EpiFFN, pg8::StaticOrder, true, true>(F.lds + RING_OFF, g, S, E, F.wave); } while (0)
#define SKINNY_SCALE(Boff, Ncols, Ooff) skinny_gemm<false>(F, WSP(bf16, WS_XB) + (size_t)MPR * PD, PD, WSP(bf16, Boff), PD, Ncols, D, WSP(bf16, Ooff) + (size_t)MPR * (Ncols), Ncols, nullptr, nullptr, WSP(float, WS_SSQS))
#define GEMM_RESID(Aoff, Boff, Kdim, Kpitch, FIN) do { skinny_gemm<true, FIN>(F, WSP(bf16, Aoff) + (size_t)MPR * (Kpitch), Kpitch, WSP(bf16, Boff), Kpitch, D, Kdim, WSP(bf16, WS_XB) + (size_t)MPR * PD, PD, nullptr, F.out + (size_t)MPR * D, WSP(float, WS_SSQS)); \
        pg8::Gemm g{WSP(bf16, Aoff), WSP(bf16, Boff), MPR, D, Kdim, Kpitch, Kpitch}; pg8::StaticOrder S; S.init(MPR, D, F.G, (int)blockIdx.x); \
        pg8::EpiResid<FIN> E{F.out, WSP(bf16, WS_XB), WSP(float, WS_SSQ), PD}; pg8::gemm_phase<pg8::EpiResid<FIN>, pg8::StaticOrder, true, true>(F.lds + RING_OFF, g, S, E, F.wave); } while (0)
    if (IN(0)) { REFRESH(); p0_prologue(F); if (BOTH(0)) GRID_BAR(); }
    if (IN(1)) { REFRESH();
        SKINNY_SCALE(WS_WINA, AIN_N, WS_ZX);
        CONVERT_PRE(CV_O1, CV_O3);
        GEMM_SCALE(WS_XB, WS_WINA, MPR, AIN_N, WS_ZX, WS_SSQ, 0);
        GEMM_SCALE(WS_MEMB, WS_WMEM, MEMR, 4096, WS_MRAW, WS_MSSQ, (MPR / 256) * (AIN_N / 256));
        CONVERT_POST(CV_O1, CV_O3);
        if (BOTH(1)) GRID_BAR();
    }
    if (IN(2)) { REFRESH(); e1_conv(F); e1_dt(F); e1_memkv(F); if (BOTH(2)) GRID_BAR(); }
    if (IN(3)) { REFRESH();
        const int nssd = (F.G >= 256) ? 192 : F.G;
        if (F.vcu < nssd) ssd_fused(F, nssd);
        if (F.G < 256 || F.vcu >= nssd) {
            mem_attn_prompt(F, WSP(bf16, WS_ZX) + ZX_QM, AIN_N, INP(I_GMEMQ), WSP(bf16, WS_MK), WSP(bf16, WS_MVT), WSP(bf16, WS_MIX) + SSM_INNER, PD, (F.G >= 256) ? nssd : 0);
            mem_attn_sample(F, WSP(bf16, WS_ZX) + ZX_QM, AIN_N, INP(I_GMEMQ), INP(I_CMEM), WSP(bf16, WS_MIX) + SSM_INNER, PD, (F.G >= 256) ? nssd : 0);
            ssd_sample(F);
        }
        if (BOTH(3)) GRID_BAR();
    }
    if (IN(4)) { REFRESH(); ssd_rescale(F); if (BOTH(4)) GRID_BAR(); }
    if (IN(5)) { }
    if (IN(6)) { REFRESH(); GEMM_RESID(WS_MIX, WS_WOUTA, D, PD, false); if (BOTH(6)) GRID_BAR(); }
    if (IN(7)) { REFRESH(); SKINNY_SCALE(WS_WUP, UP_N, WS_GU);
        CONVERT_PRE(CV_O4, CV_O5); CONVERT_PRE(CV_O6, CV_O8);
        GEMM_FFN(WS_WUP, 0);
        CONVERT_POST(CV_O4, CV_O5); CONVERT_POST(CV_O6, CV_O8);
        if (BOTH(7)) GRID_BAR(); }
    if (IN(8)) { REFRESH(); e_ffn(F, 0); if (BOTH(8)) GRID_BAR(); }
    if (IN(9)) { REFRESH();
        CONVERT_PRE(CV_O8, CV_O9); CONVERT_PRE(CV_O3, CV_O4);
        GEMM_RESID(WS_H, WS_WDOWN, DFF, PF, false);
        CONVERT_POST(CV_O8, CV_O9); CONVERT_POST(CV_O3, CV_O4);
        if (BOTH(9)) GRID_BAR(); }
    if (IN(10)) { REFRESH(); SKINNY_SCALE(WS_WKVQ, KVQ_N, WS_KVQ);
        CONVERT_PRE(CV_O5, CV_O6);
        { pg8::Gemm g{WSP(bf16, WS_XB), WSP(bf16, WS_WKVQ), MPR, KVQ_N, D, PD, PD}; pg8::StaticOrder S; S.init(MPR, KVQ_N, F.G, (int)blockIdx.x);
          pg8::EpiKVQ E{F.ws, F.out, INP(I_GKDIL), INP(I_GQDIL), (LAS float*)(F.lds + RING_BYTES)};
          pg8::gemm_phase<pg8::EpiKVQ, pg8::StaticOrder, true, true>(F.lds + RING_OFF, g, S, E, F.wave); }
        CONVERT_POST(CV_O5, CV_O6);
        if (BOTH(10)) GRID_BAR(); }
    if (IN(11)) { REFRESH();   }
    if (IN(12)) { REFRESH();
        dil_attn_prompt(F);
        if (((MPR / 256) * (UP_N / 256)) % F.G == 0) win_out_pass(F, F.vcu, F.G);
        mem_attn_prompt(F, WSP(bf16, WS_KVQ) + KQ_QM, KVQ_N, INP(I_GMEMQ) + 256, WSP(bf16, WS_MK) + (size_t)16 * 65536, WSP(bf16, WS_MVT) + (size_t)16 * 65536, WSP(bf16, WS_MIX2) + 1024, P2);
        dil_attn_sample(F);
        mem_attn_sample(F, WSP(bf16, WS_KVQ) + KQ_QM, KVQ_N, INP(I_GMEMQ) + 256, INP(I_CMEM) + (size_t)NSMP * 256 * 2048, WSP(bf16, WS_MIX2) + 1024, P2, 64);
        if (BOTH(12)) GRID_BAR();
    }
    if (IN(13)) { REFRESH(); dil_merge(F); if (BOTH(13)) GRID_BAR(); }
    if (IN(14)) { REFRESH(); GEMM_RESID(WS_MIX2, WS_WOUTB, 2048, P2, false); if (BOTH(14)) GRID_BAR(); }
    if (IN(15)) { REFRESH(); SKINNY_SCALE(WS_WUP + (size_t)UP_N * PD * 2, UP_N, WS_GU);
        { const int r_ = ((MPR / 256) * (UP_N / 256)) % F.G; REFRESH(); if (r_ != 0 && (int)blockIdx.x >= r_) win_out_pass(F, (int)blockIdx.x - r_, F.G - r_); }
        GEMM_FFN(WS_WUP + (size_t)UP_N * PD * 2, 1); if (BOTH(15)) GRID_BAR(); }
    if (IN(16)) { REFRESH(); e_ffn(F, 1); if (BOTH(16)) GRID_BAR(); }
    if (IN(17)) { REFRESH(); GEMM_RESID(WS_H, WS_WDOWN + (size_t)D * PF * 2, DFF, PF, true); }
#undef IN
#undef BOTH
}

extern "C" void kernel_launch(void* const* d_in, const int* in_sizes, int n_in, void* d_out, int out_size, void* d_ws, size_t ws_size, hipStream_t stream) {
    static int grid = 0;
    if (grid == 0) {
        if (n_in != 34 || (size_t)out_size != O_END || ws_size < WS_END) { fprintf(stderr, "kernel_launch: shape mismatch: n_in %d out %d (want %zu) ws %zu (want %zu)\n", n_in, out_size, (size_t)O_END, ws_size, (size_t)WS_END); grid = -1; return; }
        int dev = 0, cus = 0, per_cu = 0;
        if (hipGetDevice(&dev) != hipSuccess || hipDeviceGetAttribute(&cus, hipDeviceAttributeMultiprocessorCount, dev) != hipSuccess) { grid = -1; return; }
        if (hipFuncSetAttribute((const void*)yoco_fwd, hipFuncAttributeMaxDynamicSharedMemorySize, LDS_BYTES) != hipSuccess) { fprintf(stderr, "kernel_launch: hipFuncSetAttribute failed\n"); grid = -1; return; }
        if (hipOccupancyMaxActiveBlocksPerMultiprocessor(&per_cu, (const void*)yoco_fwd, NTHR, LDS_BYTES) != hipSuccess || per_cu < 1) { fprintf(stderr, "kernel_launch: occupancy query says %d\n", per_cu); (void)hipGetLastError(); grid = -1; return; }
        grid = cus;
    }
    if (grid < 0) return;
    (void)hipMemsetAsync((char*)d_ws + WS_CTL, 0, CTL_ZERO_BYTES, stream);
    Args a{};
    for (int i = 0; i < 34; ++i) a.in[i] = (const float*)d_in[i];
    a.out = (float*)d_out; a.ws = (unsigned char*)d_ws;
#if MK_SPLIT
    for (int p = 0; p < N_PHASES; ++p) { a.ph_lo = p; a.ph_hi = p + 1; hipLaunchKernelGGL(yoco_fwd, dim3(grid), dim3(NTHR), LDS_BYTES, stream, a); }
#else
    a.ph_lo = 0; a.ph_hi = N_PHASES; hipLaunchKernelGGL(yoco_fwd, dim3(grid), dim3(NTHR), LDS_BYTES, stream, a);
#endif
}
```
